# Optimizing an MI355X kernel written in HIP

```python
import math
import jax, jax.numpy as jnp
from jax import lax
import numpy as np

D_MODEL = 2048
BATCH = 8
SEQ = 2048
DEPTH = 2

CTX_LEN = 256
GRID_W = 64
MLP_HIDDEN = 4 * D_MODEL
NORM_EPS = 1e-6
NEG_INF = -1e30
ROPE_BASE = 10000.0
N_EVEN = (DEPTH + 1) // 2
N_ODD = DEPTH // 2

NA_HEADS = 8
NA_HEAD_DIM = 128
NA_WIDTH = NA_HEADS * NA_HEAD_DIM
NA_WIN_ROWS = 8
NA_WIN_COLS = 16
NA_QCOLS = 16
NA_KCOLS = NA_QCOLS + NA_WIN_COLS

S5_WIDTH = D_MODEL // 2
S5_GROUP = 16
S5_GROUPS = S5_WIDTH // S5_GROUP
S5_STATE = 64
S5_DT_MIN = 1e-3
S5_DT_MAX = 1e-1

AB_IN = 3 * NA_WIDTH + S5_WIDTH
AB_OUT = NA_WIDTH + S5_WIDTH

GLA_HEADS = 4
GLA_DK = D_MODEL // 2 // GLA_HEADS
GLA_DV = D_MODEL // GLA_HEADS
GLA_QK = GLA_HEADS * GLA_DK
GLA_VW = GLA_HEADS * GLA_DV
GLA_RANK = 16
GLA_TAU = 16.0
GLA_CHUNK = 64
GLA_IN = 2 * GLA_QK + 2 * GLA_VW + 2 * GLA_RANK

kernel_name = 'hybrid_natten_s5_gla_dit'


def rmsnorm(x, g):
    xf = x.astype(jnp.float32)
    return xf * lax.rsqrt(jnp.mean(xf * xf, axis=-1, keepdims=True) + NORM_EPS) * g.astype(jnp.float32)


def modulate(h, shift, scale):
    return h * (1.0 + scale) + shift


def sq_relu_mlp(h, w1, w2):
    return jnp.square(jax.nn.relu(h @ w1)) @ w2


def rope_1d(x, pos):
    d = x.shape[-1]
    freqs = ROPE_BASE ** (-jnp.arange(0, d, 2, dtype=jnp.float32) / d)
    ang = pos[:, None] * freqs[None, :]
    cos = jnp.cos(ang)[None, :, None, :]
    sin = jnp.sin(ang)[None, :, None, :]
    x1, x2 = x[..., : d // 2], x[..., d // 2:]
    return jnp.concatenate([x1 * cos - x2 * sin, x1 * sin + x2 * cos], axis=-1)


def axial_rope(x, row_pos, col_pos):
    half = x.shape[-1] // 2
    return jnp.concatenate([rope_1d(x[..., :half], row_pos), rope_1d(x[..., half:], col_pos)], axis=-1)


def ctx_attention(q, k, v):
    s = jnp.einsum('bqhd,bkhd->bhqk', q, k) * q.shape[-1] ** -0.5
    return jnp.einsum('bhqk,bkhd->bqhd', jax.nn.softmax(s, axis=-1), v)


def neighbourhood_attention(q, k, v, kc, vc, rel_bias):
    B, S, H, dh = q.shape
    L = kc.shape[1]
    rows = S // GRID_W
    wh = min(NA_WIN_ROWS, rows)
    n_cb = GRID_W // NA_QCOLS
    scale = dh ** -0.5
    qg = q.reshape(B, rows, GRID_W, H, dh)
    kg = k.reshape(B, rows, GRID_W, H, dh)
    vg = v.reshape(B, rows, GRID_W, H, dh)

    def block(idx):
        r = idx // n_cb
        c0 = (idx % n_cb) * NA_QCOLS
        rs = jnp.clip(r - wh // 2, 0, rows - wh)
        ks0 = jnp.clip(c0 - NA_WIN_COLS // 2, 0, GRID_W - NA_KCOLS)
        qb = lax.dynamic_slice(qg, (0, r, c0, 0, 0), (B, 1, NA_QCOLS, H, dh))[:, 0]
        kb = lax.dynamic_slice(kg, (0, rs, ks0, 0, 0), (B, wh, NA_KCOLS, H, dh)).reshape(B, wh * NA_KCOLS, H, dh)
        vb = lax.dynamic_slice(vg, (0, rs, ks0, 0, 0), (B, wh, NA_KCOLS, H, dh)).reshape(B, wh * NA_KCOLS, H, dh)
        qcols = c0 + jnp.arange(NA_QCOLS)
        kcols = ks0 + jnp.arange(NA_KCOLS)
        krows = rs + jnp.arange(wh)
        win_start = jnp.clip(qcols - NA_WIN_COLS // 2, 0, GRID_W - NA_WIN_COLS)
        col_ok = (kcols[None, :] >= win_start[:, None]) & (kcols[None, :] < win_start[:, None] + NA_WIN_COLS)
        ri = krows - r + NA_WIN_ROWS - 1
        ci = jnp.clip(kcols[None, :] - qcols[:, None] + NA_WIN_COLS - 1, 0, 2 * NA_WIN_COLS - 2)
        bias = rel_bias[:, ri[:, None, None], ci[None, :, :]]
        bias = bias.transpose(0, 2, 1, 3).reshape(H, NA_QCOLS, wh * NA_KCOLS).astype(jnp.float32)
        mask = jnp.broadcast_to(col_ok[:, None, :], (NA_QCOLS, wh, NA_KCOLS)).reshape(NA_QCOLS, wh * NA_KCOLS)
        s_win = jnp.einsum('bqhd,bkhd->bhqk', qb, kb) * scale + bias
        s_win = jnp.where(mask, s_win, NEG_INF)
        s_ctx = jnp.einsum('bqhd,blhd->bhql', qb, kc) * scale
        p = jax.nn.softmax(jnp.concatenate([s_ctx, s_win], axis=-1), axis=-1)
        return (jnp.einsum('bhql,blhd->bqhd', p[..., :L], vc)
                + jnp.einsum('bhqk,bkhd->bqhd', p[..., L:], vb))

    out = lax.map(block, jnp.arange(rows * n_cb))
    out = out.reshape(rows, n_cb, B, NA_QCOLS, H, dh).transpose(2, 0, 1, 3, 4, 5)
    return out.reshape(B, S, H, dh)


def s5_discretize(lam_re, lam_im, log_dt, b_re, b_im):
    f32 = jnp.float32
    lam_re, lam_im = lam_re.astype(f32), lam_im.astype(f32)
    b_re, b_im = b_re.astype(f32), b_im.astype(f32)
    dt = jnp.exp(log_dt.astype(f32))[:, None]
    mag = jnp.exp(lam_re * dt)
    a_re = mag * jnp.cos(lam_im * dt)
    a_im = mag * jnp.sin(lam_im * dt)
    den = lam_re * lam_re + lam_im * lam_im
    f_re = ((a_re - 1.0) * lam_re + a_im * lam_im) / den
    f_im = (a_im * lam_re - (a_re - 1.0) * lam_im) / den
    bb_re = f_re[..., None] * b_re - f_im[..., None] * b_im
    bb_im = f_re[..., None] * b_im + f_im[..., None] * b_re
    return a_re, a_im, bb_re, bb_im


def _complex_linear_combine(e1, e2):
    a1r, a1i, b1r, b1i = e1
    a2r, a2i, b2r, b2i = e2
    return (a1r * a2r - a1i * a2i,
            a1r * a2i + a1i * a2r,
            a2r * b1r - a2i * b1i + b2r,
            a2r * b1i + a2i * b1r + b2i)


def s5_scan(u, lam_re, lam_im, log_dt, b_re, b_im, c_re, c_im, h0_re, h0_im, reverse):
    a_re, a_im, bb_re, bb_im = s5_discretize(lam_re, lam_im, log_dt, b_re, b_im)
    bu_re = jnp.einsum('btgc,gpc->btgp', u, bb_re)
    bu_im = jnp.einsum('btgc,gpc->btgp', u, bb_im)
    first = -1 if reverse else 0
    last = 0 if reverse else -1
    bu_re = bu_re.at[:, first].add(a_re * h0_re - a_im * h0_im)
    bu_im = bu_im.at[:, first].add(a_re * h0_im + a_im * h0_re)
    T = u.shape[1]
    ar = jnp.broadcast_to(a_re, (1, T) + a_re.shape)
    ai = jnp.broadcast_to(a_im, (1, T) + a_im.shape)
    _, _, h_re, h_im = lax.associative_scan(_complex_linear_combine, (ar, ai, bu_re, bu_im),
                                            reverse=reverse, axis=1)
    y = (jnp.einsum('btgp,gcp->btgc', h_re, c_re.astype(jnp.float32))
         - jnp.einsum('btgp,gcp->btgc', h_im, c_im.astype(jnp.float32)))
    return y, h_re[:, last], h_im[:, last]


def s5_bidirectional(ul, uc, lam_re, lam_im, log_dt, b_re, b_im, c_re, c_im, d_skip, glu_w, glu_b, ctx_out):
    B = ul.shape[0]
    grp = lambda u: u.reshape(u.shape[0], u.shape[1], S5_GROUPS, S5_GROUP).astype(jnp.float32)
    ul_g, uc_g = grp(ul), grp(uc)
    zero = jnp.zeros((B, S5_GROUPS, S5_STATE), jnp.float32)
    yl = 0.0
    yc = 0.0
    for dr, rev in enumerate((False, True)):
        prm = (lam_re[dr], lam_im[dr], log_dt[dr], b_re[dr], b_im[dr], c_re[dr], c_im[dr])
        ycd, hr, hi = s5_scan(uc_g, *prm, zero, zero, rev)
        yld, _, _ = s5_scan(ul_g, *prm, hr, hi, rev)
        yl = yl + yld
        yc = yc + ycd

    def finish(y, u):
        y = y.reshape(u.shape) + d_skip * u
        gl = jax.nn.gelu(y, approximate=False)
        return gl * jax.nn.sigmoid(gl @ glu_w + glu_b)

    return finish(yl, ul), (finish(yc, uc) if ctx_out else None)


def ab_mixer(hl, hc, w_in, w_out, rel_bias, lam_re, lam_im, log_dt, b_re, b_im, c_re, c_im,
             d_skip, glu_w, glu_b, ctx_out):
    B, S, _ = hl.shape
    L = hc.shape[1]
    cuts = [NA_WIDTH, 2 * NA_WIDTH, 3 * NA_WIDTH]
    ql, kl, vl, ul = jnp.split(hl @ w_in, cuts, axis=-1)
    qc, kc, vc, uc = jnp.split(hc @ w_in, cuts, axis=-1)
    heads = lambda z: z.reshape(z.shape[0], z.shape[1], NA_HEADS, NA_HEAD_DIM)
    kc_h, vc_h = heads(kc), heads(vc)
    na_l = neighbourhood_attention(heads(ql), heads(kl), heads(vl), kc_h, vc_h, rel_bias).reshape(B, S, NA_WIDTH)
    s5_l, s5_c = s5_bidirectional(ul, uc, lam_re, lam_im, log_dt, b_re, b_im, c_re, c_im,
                                  d_skip, glu_w, glu_b, ctx_out)
    yl = jnp.concatenate([na_l, s5_l], axis=-1) @ w_out
    if not ctx_out:
        return yl, None
    na_c = ctx_attention(heads(qc), kc_h, vc_h).reshape(B, L, NA_WIDTH)
    yc = jnp.concatenate([na_c, s5_c], axis=-1) @ w_out
    return yl, yc


def gla_chunked(q, k, v, log_a, s0):
    B, T, H, dk = q.shape
    dv = v.shape[-1]
    n = T // GLA_CHUNK
    q = q.reshape(B, n, GLA_CHUNK, H, dk)
    k = k.reshape(B, n, GLA_CHUNK, H, dk)
    v = v.reshape(B, n, GLA_CHUNK, H, dv)
    bc = jnp.cumsum(log_a.reshape(B, n, GLA_CHUNK, H, dk), axis=2)
    b_last = bc[:, :, -1:]
    q_in = q * jnp.exp(bc)
    k_in = k * jnp.exp(-bc)
    k_end = k * jnp.exp(b_last - bc)
    causal = jnp.tril(jnp.ones((GLA_CHUNK, GLA_CHUNK), dtype=bool))
    att = jnp.where(causal, jnp.einsum('bnihd,bnjhd->bnhij', q_in, k_in), 0.0)
    o_intra = jnp.einsum('bnhij,bnjhv->bnihv', att, v)
    decay = jnp.exp(b_last[:, :, 0])

    def step(state, xs):
        qi, ke, vv, dec = xs
        o = jnp.einsum('blhd,bhdv->blhv', qi, state)
        state = dec[..., None] * state + jnp.einsum('blhd,blhv->bhdv', ke, vv)
        return state, o

    xs = tuple(jnp.moveaxis(t, 1, 0) for t in (q_in, k_end, v, decay))
    s_fin, o_inter = lax.scan(step, s0, xs)
    o = o_intra + jnp.moveaxis(o_inter, 0, 1)
    return o.reshape(B, T, H, dv), s_fin


def gla_chunked_reverse(q, k, v, log_a, s0):
    o, s_fin = gla_chunked(jnp.flip(q, 1), jnp.flip(k, 1), jnp.flip(v, 1), jnp.flip(log_a, 1), s0)
    return jnp.flip(o, 1), s_fin


def gla_mixer(hl, hc, row_pos, col_pos, w_in, w_a2, b_a, norm_g, w_out, ctx_out):
    cuts = [GLA_QK, 2 * GLA_QK, 2 * GLA_QK + GLA_VW, 2 * GLA_QK + 2 * GLA_VW]

    def project(h):
        B, T, _ = h.shape
        q, k, v, g, a = jnp.split(h @ w_in, cuts, axis=-1)
        q = q.reshape(B, T, GLA_HEADS, GLA_DK).astype(jnp.float32) * GLA_DK ** -0.5
        k = k.reshape(B, T, GLA_HEADS, GLA_DK).astype(jnp.float32)
        v = v.reshape(B, T, GLA_HEADS, GLA_DV).astype(jnp.float32)
        g = g.reshape(B, T, GLA_HEADS, GLA_DV)
        log_a = [jax.nn.log_sigmoid((a[..., d * GLA_RANK:(d + 1) * GLA_RANK] @ w_a2[d] + b_a[d])
                                    .astype(jnp.float32)).reshape(B, T, GLA_HEADS, GLA_DK) / GLA_TAU
                 for d in range(2)]
        return q, k, v, g, log_a

    ql, kl, vl, gl, la_l = project(hl)
    qc, kc, vc, gc, la_c = project(hc)
    ql = axial_rope(ql, row_pos, col_pos)
    kl = axial_rope(kl, row_pos, col_pos)
    B = hl.shape[0]
    s0 = jnp.zeros((B, GLA_HEADS, GLA_DK, GLA_DV), jnp.float32)
    oc_f, sc_f = gla_chunked(qc, kc, vc, la_c[0], s0)
    oc_b, sc_b = gla_chunked_reverse(qc, kc, vc, la_c[1], s0)
    ol_f, _ = gla_chunked(ql, kl, vl, la_l[0], sc_f)
    ol_b, _ = gla_chunked_reverse(ql, kl, vl, la_l[1], sc_b)

    def finish(o, g):
        Bo, T = o.shape[0], o.shape[1]
        o = rmsnorm(o, norm_g) * jax.nn.silu(g)
        return o.reshape(Bo, T, GLA_VW) @ w_out

    return finish(ol_f + ol_b, gl), (finish(oc_f + oc_b, gc) if ctx_out else None)


def setup_inputs(seed: int = 0) -> dict:
    key = jax.random.key(seed)
    keys = iter(jax.random.split(key, 32))
    f32 = jnp.float32

    def nrm(shape, scale):
        return jax.random.normal(next(keys), shape, f32) * scale

    D = D_MODEL
    G, P, CG = S5_GROUPS, S5_STATE, S5_GROUP
    x = nrm((BATCH, SEQ, D), 1.0)
    c = nrm((BATCH, D), 1.0)
    ctx = nrm((BATCH, CTX_LEN, D), 1.0)
    c_ctx = nrm((D,), 1.0)
    ada_w = nrm((DEPTH, D, 6 * D), D ** -0.5)
    ada_b = nrm((DEPTH, 6 * D), 0.02)
    norm1_g = 1.0 + nrm((DEPTH, D), 0.05)
    norm2_g = 1.0 + nrm((DEPTH, D), 0.05)
    mlp_w1 = nrm((DEPTH, D, MLP_HIDDEN), D ** -0.5)
    mlp_w2 = nrm((DEPTH, MLP_HIDDEN, D), MLP_HIDDEN ** -0.5)
    final_g = 1.0 + nrm((D,), 0.05)
    ab_w_in = nrm((N_EVEN, D, AB_IN), D ** -0.5)
    ab_w_out = nrm((N_EVEN, AB_OUT, D), AB_OUT ** -0.5)
    na_rel_bias = nrm((N_EVEN, NA_HEADS, 2 * NA_WIN_ROWS - 1, 2 * NA_WIN_COLS - 1), 0.1)
    s5_lambda_re = -0.5 + nrm((N_EVEN, 2, G, P), 0.01)
    s5_lambda_im = jnp.pi * jnp.arange(P, dtype=f32) + nrm((N_EVEN, 2, G, P), 0.01)
    s5_log_dt = jax.random.uniform(next(keys), (N_EVEN, 2, G), f32,
                                   math.log(S5_DT_MIN), math.log(S5_DT_MAX))
    s5_b_re = nrm((N_EVEN, 2, G, P, CG), (2 * CG) ** -0.5)
    s5_b_im = nrm((N_EVEN, 2, G, P, CG), (2 * CG) ** -0.5)
    s5_c_re = nrm((N_EVEN, 2, G, CG, P), P ** -0.5)
    s5_c_im = nrm((N_EVEN, 2, G, CG, P), P ** -0.5)
    s5_d = nrm((N_EVEN, S5_WIDTH), 1.0)
    s5_glu_w = nrm((N_EVEN, S5_WIDTH, S5_WIDTH), S5_WIDTH ** -0.5)
    s5_glu_b = nrm((N_EVEN, S5_WIDTH), 0.02)
    gla_w_in = nrm((N_ODD, D, GLA_IN), D ** -0.5)
    gla_w_a2 = nrm((N_ODD, 2, GLA_RANK, GLA_QK), GLA_RANK ** -0.5)
    gla_b_a = nrm((N_ODD, 2, GLA_QK), 0.1)
    gla_norm_g = 1.0 + nrm((N_ODD, GLA_DV), 0.05)
    gla_w_out = nrm((N_ODD, GLA_VW, D), GLA_VW ** -0.5)
    return {'x': x, 'c': c, 'ctx': ctx, 'c_ctx': c_ctx,
            'ada_w': ada_w, 'ada_b': ada_b, 'norm1_g': norm1_g, 'norm2_g': norm2_g,
            'mlp_w1': mlp_w1, 'mlp_w2': mlp_w2, 'final_g': final_g,
            'ab_w_in': ab_w_in, 'ab_w_out': ab_w_out, 'na_rel_bias': na_rel_bias,
            's5_lambda_re': s5_lambda_re, 's5_lambda_im': s5_lambda_im, 's5_log_dt': s5_log_dt,
            's5_b_re': s5_b_re, 's5_b_im': s5_b_im, 's5_c_re': s5_c_re, 's5_c_im': s5_c_im,
            's5_d': s5_d, 's5_glu_w': s5_glu_w, 's5_glu_b': s5_glu_b,
            'gla_w_in': gla_w_in, 'gla_w_a2': gla_w_a2, 'gla_b_a': gla_b_a,
            'gla_norm_g': gla_norm_g, 'gla_w_out': gla_w_out}


def reference(x, c, ctx, c_ctx, ada_w, ada_b, norm1_g, norm2_g, mlp_w1, mlp_w2, final_g,
              ab_w_in, ab_w_out, na_rel_bias, s5_lambda_re, s5_lambda_im, s5_log_dt,
              s5_b_re, s5_b_im, s5_c_re, s5_c_im, s5_d, s5_glu_w, s5_glu_b,
              gla_w_in, gla_w_a2, gla_b_a, gla_norm_g, gla_w_out):
    f32 = jnp.float32
    S = x.shape[1]
    t = jnp.arange(S)
    row_pos = (t // GRID_W).astype(f32)
    col_pos = (t % GRID_W).astype(f32)
    xl = x.astype(f32)
    xc = ctx.astype(f32)
    for i in range(DEPTH):
        last = i == DEPTH - 1
        mod_l = (jax.nn.silu(c.astype(f32)) @ ada_w[i] + ada_b[i])[:, None, :]
        mod_c = (jax.nn.silu(c_ctx.astype(f32)) @ ada_w[i] + ada_b[i])[None, None, :]
        sh1l, sc1l, g1l, sh2l, sc2l, g2l = jnp.split(mod_l, 6, axis=-1)
        sh1c, sc1c, g1c, sh2c, sc2c, g2c = jnp.split(mod_c, 6, axis=-1)
        hl = modulate(rmsnorm(xl, norm1_g[i]), sh1l, sc1l)
        hc = modulate(rmsnorm(xc, norm1_g[i]), sh1c, sc1c)
        j = i // 2
        if i % 2 == 0:
            yl, yc = ab_mixer(hl, hc, ab_w_in[j], ab_w_out[j], na_rel_bias[j],
                              s5_lambda_re[j], s5_lambda_im[j], s5_log_dt[j],
                              s5_b_re[j], s5_b_im[j], s5_c_re[j], s5_c_im[j],
                              s5_d[j], s5_glu_w[j], s5_glu_b[j], not last)
        else:
            yl, yc = gla_mixer(hl, hc, row_pos, col_pos, gla_w_in[j], gla_w_a2[j], gla_b_a[j],
                               gla_norm_g[j], gla_w_out[j], not last)
        xl = xl + g1l * yl
        xl = xl + g2l * sq_relu_mlp(modulate(rmsnorm(xl, norm2_g[i]), sh2l, sc2l), mlp_w1[i], mlp_w2[i])
        if not last:
            xc = xc + g1c * yc
            xc = xc + g2c * sq_relu_mlp(modulate(rmsnorm(xc, norm2_g[i]), sh2c, sc2c), mlp_w1[i], mlp_w2[i])
    return rmsnorm(xl, final_g).astype(x.dtype)
```

```cpp
#include <hip/hip_runtime.h>
#include <hip/hip_cooperative_groups.h>
#include <cstdio>
#include <cstdint>
namespace cg = cooperative_groups;
namespace pg8 {
#define PG8_LAS __attribute__((address_space(3)))
typedef unsigned short bf16_t;
typedef short bf16x8 __attribute__((ext_vector_type(8)));
typedef float f32x4 __attribute__((ext_vector_type(4)));
typedef unsigned u32x4 __attribute__((ext_vector_type(4)));
constexpr int BM = 256, BK = 64, HALF = 128, HTB = HALF * BK * 2  , STAGE_BYTES = 8 * HTB, NXCD = 8, WGM = 8;

__host__ __device__ __forceinline__ int lds_byte(int r, int c) { const int st = (r >> 4) * 2 + (c >> 5), rr = r & 15, cc = c & 31, ob = rr * 64 + cc * 2; return st * 1024 + (ob ^ (((ob >> 9) & 1) << 5)); }
__host__ __device__ __forceinline__ void stage_rc(int b, int& R, int& C) { const int st = b / 1024, sb = b % 1024, swz = sb ^ (((sb >> 9) & 1) << 5); R = (st >> 1) * 16 + swz / 64; C = (st & 1) * 32 + (swz % 64) / 2; }
__host__ __device__ __forceinline__ int perm32(int rho) { const int n = rho >> 4, i = rho & 15; return 8 * (i >> 2) + 4 * n + (i & 3); }

struct Unit { int pm, pn, ks; };
struct Gemm { const bf16_t* A; const bf16_t* Bt; int M, N, K, KL; };

struct StaticOrder {
    int nM, nN, nwg, G, c;
    __host__ __device__ void init(int M, int N, int G_, int c_) { nM = M / BM; nN = N / BM; nwg = nM * nN; G = G_; c = c_; }
    __host__ __device__ bool next(int i, Unit& u) const {
        const long L = (long)i * G + c; if (L >= nwg) return false;
        int wgid = (int)L; { const int q = nwg / NXCD, r = nwg % NXCD, xcd = wgid % NXCD, off = wgid / NXCD; wgid = (xcd < r ? xcd * (q + 1) : r * (q + 1) + (xcd - r) * q) + off; }
        const int nig = WGM * nN, gid = wgid / nig, fm = gid * WGM, gsz = (nM - fm) < WGM ? (nM - fm) : WGM;
        u.pm = fm + ((wgid % nig) % gsz); u.pn = (wgid % nig) / gsz; u.ks = 0; return true;
    }
    __device__ __forceinline__ void a_ready(const Unit&) const {}
    __device__ __forceinline__ void done(const Unit&) const {}
};
typedef __bf16 bf16v2_t0 __attribute__((ext_vector_type(2))); typedef float f32x2_t0 __attribute__((ext_vector_type(2)));
__device__ __forceinline__ unsigned cvt_pk_bf16(float lo, float hi) { const f32x2_t0 f = {lo, hi}; const bf16v2_t0 v = __builtin_convertvector(f, bf16v2_t0); return __builtin_bit_cast(unsigned, v); }
template <class Epi, class Sched, bool ALIGN_EPI = false, bool SP2 = false>
__device__ __forceinline__ void gemm_phase(PG8_LAS unsigned char* lds, const Gemm g, const Sched& S, const Epi& E) {
    const int tid = threadIdx.x, wid = __builtin_amdgcn_readfirstlane(tid >> 6), lane = tid & 63, wr = wid >> 2, wc = wid & 3, fr = lane & 15, fq = lane >> 4;
    const int K = g.K, nt = (g.KL ? g.KL : g.K) / BK; const size_t kspan = (size_t)g.KL * 2;
    unsigned voffA[2], voffB[2];
#pragma unroll
    for (int i = 0; i < 2; ++i) { int R, C; stage_rc(tid * 16 + i * 8192, R, C); const int Rb = Epi::PERM ? ((R & ~31) + perm32(R & 31)) : R;
        voffA[i] = (unsigned)(R * K + C) * 2u; voffB[i] = (unsigned)(Rb * K + C) * 2u; }
    const size_t kstep = (size_t)(BK * 2);
    const size_t hstep = (size_t)HALF * K * 2;
    const size_t tstep = 2 * hstep;
    const unsigned ldsw = (unsigned)wid * 1024u;
    const int aoff = lds_byte(wr * 64 + fr, fq * 8), boff = lds_byte(wc * 32 + fr, fq * 8);
#define PG8_SA(b, h) (((b) * 2 + (h)) * HTB)
#define PG8_SB(b, h) ((4 + (b) * 2 + (h)) * HTB)
#define PG8_STAGE(bufoff, gbase, voff) do { _Pragma("unroll") for (int _i = 0; _i < 2; ++_i) \
        __builtin_amdgcn_global_load_lds((const unsigned*)((const char*)(gbase) + (voff)[_i]), (PG8_LAS unsigned*)(lds + (bufoff) + ldsw + _i * 8192), 16, 0, 0); } while (0)
#define PG8_LDA(dst, b, h) do { _Pragma("unroll") for (int m = 0; m < 4; ++m) _Pragma("unroll") for (int k = 0; k < 2; ++k) dst[m][k] = *(const PG8_LAS bf16x8*)(lds + PG8_SA(b, h) + aoff + m * 2048 + k * 1024); } while (0)
#define PG8_LDB(dst, b, h) do { _Pragma("unroll") for (int n = 0; n < 2; ++n) _Pragma("unroll") for (int k = 0; k < 2; ++k) dst[n][k] = *(const PG8_LAS bf16x8*)(lds + PG8_SB(b, h) + boff + n * 2048 + k * 1024); } while (0)
#define PG8_MMA(ai, bj, At, Bt) do { __builtin_amdgcn_s_setprio(1); _Pragma("unroll") for (int m = 0; m < 4; ++m) _Pragma("unroll") for (int n = 0; n < 2; ++n) _Pragma("unroll") for (int k = 0; k < 2; ++k) \
        acc[ai][bj][m][n] = __builtin_amdgcn_mfma_f32_16x16x32_bf16(Bt[n][k], At[m][k], acc[ai][bj][m][n], 0, 0, 0); __builtin_amdgcn_s_setprio(0); } while (0)
#define PG8_WAIT_V(n) asm volatile("s_waitcnt vmcnt(" #n ")" ::: "memory")
#define PG8_WAIT_L(n) asm volatile("s_waitcnt lgkmcnt(" #n ")" ::: "memory")
#define PG8_BAR __builtin_amdgcn_s_barrier()
#define PG8_SCHED __builtin_amdgcn_sched_barrier(0)
    Unit cur, nxt; int ui = 0;
    if (!S.next(0, cur)) return;
    f32x4 acc[2][2][4][2];
#pragma unroll
    for (int a = 0; a < 2; ++a)
#pragma unroll
        for (int b = 0; b < 2; ++b)
#pragma unroll
            for (int m = 0; m < 4; ++m)
#pragma unroll
                for (int n = 0; n < 2; ++n) acc[a][b][m][n] = (f32x4){0.f, 0.f, 0.f, 0.f};
    bf16x8 At[4][2], B0[2][2], B1[2][2];
    const char* cA = (const char*)g.A + (size_t)cur.pm * tstep + (size_t)cur.ks * kspan; const char* cB = (const char*)g.Bt + (size_t)cur.pn * tstep + (size_t)cur.ks * kspan;
    S.a_ready(cur);
    if constexpr (SP2) {
        PG8_STAGE(PG8_SB(0, 0), cB, voffB); PG8_STAGE(PG8_SB(0, 1), cB + hstep, voffB); PG8_STAGE(PG8_SA(0, 0), cA, voffA); PG8_STAGE(PG8_SA(0, 1), cA + hstep, voffA);
        if (wr == 1) PG8_BAR;
        PG8_WAIT_V(2); PG8_BAR;
        PG8_STAGE(PG8_SB(1, 0), cB + kstep, voffB); PG8_STAGE(PG8_SA(1, 0), cA + kstep, voffA); PG8_STAGE(PG8_SB(1, 1), cB + hstep + kstep, voffB);
        PG8_WAIT_V(6); PG8_BAR;
    } else {
        PG8_STAGE(PG8_SB(0, 0), cB, voffB); PG8_STAGE(PG8_SA(0, 0), cA, voffA); PG8_STAGE(PG8_SB(0, 1), cB + hstep, voffB); PG8_STAGE(PG8_SA(0, 1), cA + hstep, voffA);
        if (wr == 1) PG8_BAR;
        PG8_WAIT_V(4); PG8_BAR;
        PG8_STAGE(PG8_SB(1, 0), cB + kstep, voffB); PG8_STAGE(PG8_SA(1, 0), cA + kstep, voffA); PG8_STAGE(PG8_SB(1, 1), cB + hstep + kstep, voffB);
        PG8_WAIT_V(6); PG8_BAR;
    }
    for (;;) {
        const bool has_next = S.next(ui + 1, nxt);
        const char* nA = has_next ? (const char*)g.A + (size_t)nxt.pm * tstep + (size_t)nxt.ks * kspan : cA; const char* nB = has_next ? (const char*)g.Bt + (size_t)nxt.pn * tstep + (size_t)nxt.ks * kspan : cB;
        for (int t = 0; t < nt; t += 2) {
            const bool last = (t == nt - 2);
            const char* a1 = cA + (size_t)(t + 1) * kstep;
            const char* a2 = last ? nA : cA + (size_t)(t + 2) * kstep; const char* b2 = last ? nB : cB + (size_t)(t + 2) * kstep;
            const char* a3 = a2 + kstep; const char* b3 = b2 + kstep;
            if (last && has_next) S.a_ready(nxt);
            if constexpr (SP2) {
            PG8_LDB(B0, 0, 0); PG8_LDB(B1, 0, 1); PG8_SCHED; PG8_LDA(At, 0, 0); PG8_STAGE(PG8_SA(1, 1), a1 + hstep, voffA);
            PG8_WAIT_V(8); PG8_WAIT_L(0); PG8_BAR; PG8_MMA(0, 0, At, B0); PG8_MMA(0, 1, At, B1); PG8_BAR; PG8_SCHED;
            PG8_LDA(At, 0, 1); PG8_STAGE(PG8_SB(0, 0), b2, voffB); PG8_STAGE(PG8_SB(0, 1), b2 + hstep, voffB); PG8_STAGE(PG8_SA(0, 0), a2, voffA);
            PG8_WAIT_V(8); PG8_WAIT_L(0); PG8_BAR; PG8_MMA(1, 0, At, B0); PG8_MMA(1, 1, At, B1); PG8_BAR; PG8_SCHED;
            PG8_LDB(B0, 1, 0); PG8_LDB(B1, 1, 1); PG8_SCHED; PG8_LDA(At, 1, 0); PG8_STAGE(PG8_SA(0, 1), a2 + hstep, voffA);
            PG8_WAIT_V(8); PG8_WAIT_L(0); PG8_BAR; PG8_MMA(0, 0, At, B0); PG8_MMA(0, 1, At, B1); PG8_BAR; PG8_SCHED;
            PG8_LDA(At, 1, 1); PG8_STAGE(PG8_SB(1, 0), b3, voffB); PG8_STAGE(PG8_SB(1, 1), b3 + hstep, voffB); PG8_STAGE(PG8_SA(1, 0), a3, voffA);
            PG8_WAIT_V(8); PG8_WAIT_L(0); PG8_BAR; PG8_MMA(1, 0, At, B0); PG8_MMA(1, 1, At, B1); PG8_BAR; PG8_SCHED;
            } else {
            PG8_LDB(B0, 0, 0); PG8_SCHED; PG8_LDA(At, 0, 0); PG8_STAGE(PG8_SA(1, 1), a1 + hstep, voffA);
            PG8_WAIT_L(8); PG8_BAR; PG8_WAIT_L(0); PG8_MMA(0, 0, At, B0); PG8_BAR; PG8_SCHED;
            PG8_LDB(B1, 0, 1); PG8_STAGE(PG8_SB(0, 0), b2, voffB);
            PG8_BAR; PG8_WAIT_L(0); PG8_MMA(0, 1, At, B1); PG8_BAR;
            PG8_LDA(At, 0, 1); PG8_STAGE(PG8_SA(0, 0), a2, voffA);
            PG8_BAR; PG8_WAIT_L(0); PG8_MMA(1, 0, At, B0); PG8_BAR; PG8_SCHED;
            PG8_STAGE(PG8_SB(0, 1), b2 + hstep, voffB);
            PG8_WAIT_V(6); PG8_BAR; PG8_MMA(1, 1, At, B1); PG8_BAR;
            PG8_LDB(B0, 1, 0); PG8_SCHED; PG8_LDA(At, 1, 0); PG8_STAGE(PG8_SA(0, 1), a2 + hstep, voffA);
            PG8_WAIT_L(8); PG8_BAR; PG8_WAIT_L(0); PG8_MMA(0, 0, At, B0); PG8_BAR; PG8_SCHED;
            PG8_LDB(B1, 1, 1); PG8_STAGE(PG8_SB(1, 0), b3, voffB);
            PG8_BAR; PG8_WAIT_L(0); PG8_MMA(0, 1, At, B1); PG8_BAR;
            PG8_LDA(At, 1, 1); PG8_STAGE(PG8_SA(1, 0), a3, voffA);
            PG8_BAR; PG8_WAIT_L(0); PG8_MMA(1, 0, At, B0); PG8_BAR; PG8_SCHED;
            PG8_STAGE(PG8_SB(1, 1), b3 + hstep, voffB);
            PG8_WAIT_V(6); PG8_BAR; PG8_MMA(1, 1, At, B1); PG8_BAR;
            }
        }
        if constexpr (ALIGN_EPI) { if (wr == 0) PG8_BAR; }
        if constexpr (!Epi::AFTER_DRAIN) { E(acc, cur, wr, wc, fr, fq); S.done(cur); }
        if (!has_next) break;
#pragma unroll
        for (int a = 0; a < 2; ++a)
#pragma unroll
            for (int b = 0; b < 2; ++b)
#pragma unroll
                for (int m = 0; m < 4; ++m)
#pragma unroll
                    for (int n = 0; n < 2; ++n) acc[a][b][m][n] = (f32x4){0.f, 0.f, 0.f, 0.f};
        cur = nxt; cA = nA; cB = nB; ++ui;
        if constexpr (ALIGN_EPI) { if (wr == 1) PG8_BAR; }
    }
    PG8_WAIT_V(0);
    if constexpr (!ALIGN_EPI) { if (wr == 0) PG8_BAR; }
    PG8_BAR;
    if constexpr (Epi::AFTER_DRAIN) { E.fused(acc, cur, wr, wc, fr, fq, lds, wid, lane); S.done(cur); }
#undef PG8_SA
#undef PG8_SB
#undef PG8_STAGE
#undef PG8_LDA
#undef PG8_LDB
#undef PG8_MMA
#undef PG8_WAIT_V
#undef PG8_WAIT_L
#undef PG8_BAR
#undef PG8_SCHED
}
}

#define LAS __attribute__((address_space(3)))
using pg8::bf16_t; using pg8::bf16x8; using pg8::f32x4; using pg8::u32x4;
typedef unsigned u32x2 __attribute__((ext_vector_type(2)));
typedef float f32x2 __attribute__((ext_vector_type(2)));
#define MFMA16(a, b, c) __builtin_amdgcn_mfma_f32_16x16x32_bf16((a), (b), (c), 0, 0, 0)

constexpr int ML = 16384, MC = 2048, MT = 18432, DM = 2048;
constexpr int LDS_BYTES = 155648;
constexpr int NPH = 21;
constexpr int P0LD = 4160;

constexpr size_t al256(size_t x) { return (x + 255) & ~(size_t)255; }
constexpr size_t WS_MOD   = 32768;
constexpr size_t WS_WABIN = al256(WS_MOD + (size_t)2 * 9 * 12288 * 4);
constexpr size_t WS_WABOUT = WS_WABIN + (size_t)4096 * 2048 * 2;
constexpr size_t WS_WGLU  = WS_WABOUT + (size_t)2048 * 2048 * 2;
constexpr size_t WS_W1    = WS_WGLU + (size_t)1024 * 1024 * 2;
constexpr size_t WS_W2    = WS_W1 + (size_t)2 * 8192 * 2048 * 2;
constexpr size_t WS_WGIN  = WS_W2 + (size_t)2 * 8192 * 2048 * 2;
constexpr size_t WS_WGOUT = WS_WGIN + (size_t)6400 * 2048 * 2;
constexpr size_t WS_XC    = WS_WGOUT + (size_t)2048 * 2048 * 2;
constexpr size_t WS_H     = WS_XC + (size_t)MC * DM * 4;
constexpr size_t WS_MIX   = WS_H + (size_t)MT * DM * 2;
constexpr size_t WS_BIG   = WS_MIX + (size_t)MT * DM * 2;
constexpr size_t WS_PROJ0 = WS_BIG;
constexpr size_t WS_VT0   = WS_PROJ0 + (size_t)MT * P0LD * 2;
constexpr size_t WS_YS5   = WS_VT0 + (size_t)8192 * 2304 * 2;
constexpr size_t WS_GL    = WS_YS5 + (size_t)2 * MT * 1024 * 2;
constexpr size_t WS_L0END = WS_GL + (size_t)MT * 1024 * 2;
constexpr size_t WS_HID   = WS_BIG;
constexpr size_t WS_HIDEND = WS_HID + (size_t)MT * 8192 * 2;
constexpr size_t WS_PART  = WS_HIDEND;
constexpr size_t WS_PARTEND = WS_PART + (size_t)4 * MC * DM * 4;
constexpr size_t WS_QK    = WS_BIG;
constexpr size_t WS_V1    = WS_QK + (size_t)MT * 2048 * 2;
constexpr size_t WS_G1    = WS_V1 + (size_t)MT * 2048 * 2;
constexpr size_t WS_A1    = WS_G1 + (size_t)MT * 2048 * 2;
constexpr size_t WS_QIN   = WS_A1 + (size_t)MT * 256 * 2;
constexpr size_t WS_KIN   = WS_QIN + (size_t)2 * MT * 1024 * 2;
constexpr size_t WS_DEC   = WS_KIN + (size_t)2 * MT * 1024 * 2;
constexpr size_t WS_L1END = WS_DEC + (size_t)2 * 288 * 4 * 256 * 4;
constexpr size_t WS_KENDT = WS_MIX;
constexpr size_t WS_VT1   = WS_H;
constexpr size_t cmax(size_t a, size_t b) { return a > b ? a : b; }
constexpr size_t WS_END   = cmax(cmax(WS_L0END, WS_PARTEND), WS_L1END);

struct Params { const float* in[29]; float* out; unsigned char* ws; int ph_lo, ph_hi; };

typedef __bf16 bf16v2_t __attribute__((ext_vector_type(2)));
__device__ __forceinline__ unsigned pk_bf16(float lo, float hi) { const f32x2 f = {lo, hi}; const bf16v2_t v = __builtin_convertvector(f, bf16v2_t); return __builtin_bit_cast(unsigned, v); }
__device__ __forceinline__ float bf_lo(unsigned u) { return __uint_as_float(u << 16); }
__device__ __forceinline__ float bf_hi(unsigned u) { return __uint_as_float(u & 0xffff0000u); }
__device__ __forceinline__ float bf1(bf16_t h) { return __uint_as_float((unsigned)h << 16); }
__device__ __forceinline__ float wave_sum(float v) {
#pragma unroll
    for (int o = 1; o < 64; o <<= 1) v += __shfl_xor(v, o);
    return v;
}
#define WAVE_LDS_SYNC() asm volatile("s_waitcnt lgkmcnt(0)" ::: "memory")

struct EpiBf16S {
    static constexpr bool PERM = true, AFTER_DRAIN = false;
    bf16_t *O0, *O1, *O2, *O3; int ld0, ld3; int split_cols; int act;
    __device__ __forceinline__ void operator()(const f32x4 (&acc)[2][2][4][2], const pg8::Unit& u, int wr, int wc, int fr, int fq) const {
        int colt = u.pn * 256; const int t = colt / split_cols; colt -= t * split_cols;
        bf16_t* base = t == 0 ? O0 : (t == 1 ? O1 : (t == 2 ? O2 : O3)); const int ld = t == 3 ? ld3 : ld0;
        const int row0 = u.pm * 256 + wr * 64 + fr, col0 = colt + wc * 32 + 8 * fq;
#pragma unroll
        for (int ai = 0; ai < 2; ++ai)
#pragma unroll
            for (int m = 0; m < 4; ++m) { bf16_t* rowp = base + (size_t)(row0 + ai * 128 + m * 16) * ld + col0;
#pragma unroll
                for (int bj = 0; bj < 2; ++bj) { f32x4 v0 = acc[ai][bj][m][0], v1 = acc[ai][bj][m][1];
                    if (act) {
#pragma unroll
                        for (int e = 0; e < 4; ++e) { float a = fmaxf(v0[e], 0.f), b = fmaxf(v1[e], 0.f); v0[e] = a * a; v1[e] = b * b; } }
                    u32x4 w; w.x = pk_bf16(v0[0], v0[1]); w.y = pk_bf16(v0[2], v0[3]); w.z = pk_bf16(v1[0], v1[1]); w.w = pk_bf16(v1[2], v1[3]);
                    *(u32x4*)(rowp + bj * 128) = w; } }
    }
};
struct EpiGlu {
    static constexpr bool PERM = true, AFTER_DRAIN = false;
    const bf16_t* GL; const float* bias; bf16_t* MIX;
    __device__ __forceinline__ void operator()(const f32x4 (&acc)[2][2][4][2], const pg8::Unit& u, int wr, int wc, int fr, int fq) const {
        const int row0 = u.pm * 256 + wr * 64 + fr, col0 = u.pn * 256 + wc * 32 + 8 * fq;
#pragma unroll
        for (int bj = 0; bj < 2; ++bj) { const int col = col0 + bj * 128;
            const f32x4 b0 = *(const f32x4*)(bias + col), b1 = *(const f32x4*)(bias + col + 4);
#pragma unroll
            for (int ai = 0; ai < 2; ++ai)
#pragma unroll
                for (int m = 0; m < 4; ++m) { const size_t row = (size_t)(row0 + ai * 128 + m * 16);
                    const u32x4 g = *(const u32x4*)(GL + row * 1024 + col);
                    const f32x4 v0 = acc[ai][bj][m][0] + b0, v1 = acc[ai][bj][m][1] + b1;
                    float gl[8] = {bf_lo(g.x), bf_hi(g.x), bf_lo(g.y), bf_hi(g.y), bf_lo(g.z), bf_hi(g.z), bf_lo(g.w), bf_hi(g.w)};
                    float o[8];
#pragma unroll
                    for (int e = 0; e < 4; ++e) { o[e] = gl[e] * __builtin_amdgcn_rcpf(1.f + __expf(-v0[e])); o[4 + e] = gl[4 + e] * __builtin_amdgcn_rcpf(1.f + __expf(-v1[e])); }
                    u32x4 w; w.x = pk_bf16(o[0], o[1]); w.y = pk_bf16(o[2], o[3]); w.z = pk_bf16(o[4], o[5]); w.w = pk_bf16(o[6], o[7]);
                    *(u32x4*)(MIX + row * 2048 + 1024 + col) = w; } }
    }
};
struct EpiResid {
    static constexpr bool PERM = true, AFTER_DRAIN = false;
    const float *inL, *inC; float *outL, *outC; const float* gate;
    __device__ __forceinline__ void operator()(const f32x4 (&acc)[2][2][4][2], const pg8::Unit& u, int wr, int wc, int fr, int fq) const {
        const int r0 = u.pm * 256; const bool lat = r0 < ML;
        const char* in = (const char*)(lat ? inL + (size_t)r0 * DM : inC + (size_t)(r0 - ML) * DM);
        char* out = (char*)(lat ? outL + (size_t)r0 * DM : outC + (size_t)(r0 - ML) * DM);
        const char* gp = (const char*)(gate + (size_t)(lat ? (r0 >> 11) : 8) * 12288);
        const unsigned colb = (unsigned)(u.pn * 256 + wc * 32 + 8 * fq) * 4u;
        const unsigned rowb = (unsigned)(wr * 64 + fr) * (unsigned)(DM * 4) + colb;
#pragma unroll
        for (int bj = 0; bj < 2; ++bj) {
            const f32x4 g0 = *(const f32x4*)(gp + colb + bj * 512), g1 = *(const f32x4*)(gp + colb + bj * 512 + 16);
#pragma unroll
            for (int ai = 0; ai < 2; ++ai)
#pragma unroll
                for (int m = 0; m < 4; ++m) { const unsigned off = rowb + (unsigned)((ai * 128 + m * 16) * DM * 4 + bj * 512);
                    const f32x4 x0 = *(const f32x4*)(in + off), x1 = *(const f32x4*)(in + off + 16);
                    *(f32x4*)(out + off) = x0 + g0 * acc[ai][bj][m][0];
                    *(f32x4*)(out + off + 16) = x1 + g1 * acc[ai][bj][m][1]; } }
    }
};

struct EpiPart {
    static constexpr bool PERM = true, AFTER_DRAIN = false;
    float* P;
    __device__ __forceinline__ void operator()(const f32x4 (&acc)[2][2][4][2], const pg8::Unit& u, int wr, int wc, int fr, int fq) const {
        char* out = (char*)(P + ((size_t)u.ks * MC + (size_t)(u.pm * 256 - ML)) * DM);
        const unsigned colb = (unsigned)(u.pn * 256 + wc * 32 + 8 * fq) * 4u;
        const unsigned rowb = (unsigned)(wr * 64 + fr) * (unsigned)(DM * 4) + colb;
#pragma unroll
        for (int bj = 0; bj < 2; ++bj)
#pragma unroll
            for (int ai = 0; ai < 2; ++ai)
#pragma unroll
                for (int m = 0; m < 4; ++m) { const unsigned off = rowb + (unsigned)((ai * 128 + m * 16) * DM * 4 + bj * 512);
                    *(f32x4*)(out + off) = acc[ai][bj][m][0]; *(f32x4*)(out + off + 16) = acc[ai][bj][m][1]; }
    }
};
struct SplitOrder {
    int G, c;
    __device__ bool next(int i, pg8::Unit& u) const { const long L = (long)i * G + c; if (L >= 256) return false; u.ks = (int)(L & 3); u.pn = (int)((L >> 2) & 7); u.pm = 64 + (int)(L >> 5); return true; }
    __device__ __forceinline__ void a_ready(const pg8::Unit&) const {}
    __device__ __forceinline__ void done(const pg8::Unit&) const {}
};

struct Proj1Order {
    pg8::StaticOrder S0; int G, c;
    __device__ void init(int G_, int c_) { S0.init(ML, 6400, G_, c_); G = G_; c = c_; }
    __device__ bool next(int i, pg8::Unit& u) const {
        const long L = (long)i * G + c;
        if (L < 1600) return S0.next(i, u);
        const int j = (int)(L - 1600); if (j >= 104) return false;
        const int jj = j % 13; u.pm = 64 + j / 13; u.pn = jj < 12 ? 4 + jj : 24; u.ks = 0; return true; }
    __device__ __forceinline__ void a_ready(const pg8::Unit&) const {}
    __device__ __forceinline__ void done(const pg8::Unit&) const {}
};

__device__ __forceinline__ void xpose_mat(const float* __restrict__ src, bf16_t* __restrict__ dst, int K, int N, int Npad, LAS unsigned* l32, int tid, int bid, int nblk) {
    const int nkt = K / 128, nnt = Npad / 64, tiles = nkt * nnt;
    const int n = tid & 63, kp0 = (tid >> 6) * 8;
    float cur[16], nxt[16];
    auto fetch = [&](int T, float (&v)[16]) { const int kt = T % nkt, ntile = T / nkt; const int k0 = kt * 128, n0 = ntile * 64; const bool ok = (n0 + n) < N;
        const float* sp = src + (size_t)(k0 + 2 * kp0) * N + n0 + n;
#pragma unroll
        for (int i = 0; i < 16; ++i) v[i] = ok ? sp[(size_t)i * N] : 0.f; };
    int T = bid;
    if (T < tiles) fetch(T, cur);
    for (; T < tiles; T += nblk) {
        const int kt = T % nkt, ntile = T / nkt; const int k0 = kt * 128, n0 = ntile * 64;
        const bool more = T + nblk < tiles;
        if (more) fetch(T + nblk, nxt);
#pragma unroll
        for (int i = 0; i < 8; ++i) l32[n * 65 + kp0 + i] = pk_bf16(cur[2 * i], cur[2 * i + 1]);
        __syncthreads();
#pragma unroll
        for (int q = 0; q < 2; ++q) {
            const int nn = q * 32 + (tid >> 4), j = tid & 15;
            u32x4 w; w.x = l32[nn * 65 + 4 * j]; w.y = l32[nn * 65 + 4 * j + 1]; w.z = l32[nn * 65 + 4 * j + 2]; w.w = l32[nn * 65 + 4 * j + 3];
            *(u32x4*)(dst + (size_t)(n0 + nn) * K + k0 + 8 * j) = w;
        }
        __syncthreads();
        if (more) {
#pragma unroll
            for (int i = 0; i < 16; ++i) cur[i] = nxt[i]; }
    }
}

__device__ __forceinline__ void phase_prep(const Params& p, LAS unsigned char* lds, int tid, int bid, int nblk) {
    const int wid = tid >> 6, lane = tid & 63;
    LAS float* sl = (LAS float*)lds;
    LAS float* red = sl + 9 * 2048;
    for (int i = tid; i < 9 * 2048; i += 512) { const float v = i < 8 * 2048 ? p.in[1][i] : p.in[3][i - 8 * 2048]; sl[i] = v / (1.f + expf(-v)); }
    __syncthreads();
    float* mod = (float*)(p.ws + WS_MOD);
    const int c4 = (lane & 15) * 4, ksub = lane >> 4;
    for (int item = bid; item < 384; item += nblk) {
        const int l = item / 192, cc = (item % 192) * 64;
        const float* W = p.in[4] + (size_t)l * 2048 * 12288 + cc + c4;
        f32x4 acc[9];
#pragma unroll
        for (int r = 0; r < 9; ++r) acc[r] = (f32x4){0.f, 0.f, 0.f, 0.f};
        const int k0 = wid * 256 + ksub;
        for (int kk = 0; kk < 256; kk += 32) {
            f32x4 w[8];
#pragma unroll
            for (int u = 0; u < 8; ++u) w[u] = *(const f32x4*)(W + (size_t)(k0 + kk + 4 * u) * 12288);
#pragma unroll
            for (int u = 0; u < 8; ++u)
#pragma unroll
                for (int r = 0; r < 9; ++r) acc[r] += w[u] * sl[r * 2048 + k0 + kk + 4 * u];
        }
#pragma unroll
        for (int r = 0; r < 9; ++r) {
#pragma unroll
            for (int e = 0; e < 4; ++e) { float v = acc[r][e]; v += __shfl_xor(v, 16); v += __shfl_xor(v, 32); acc[r][e] = v; }
            if (ksub == 0) *(LAS f32x4*)(red + (wid * 9 + r) * 64 + c4) = acc[r]; }
        __syncthreads();
        for (int o = tid; o < 576; o += 512) { const int r = o >> 6, c = o & 63; float s_ = 0.f;
#pragma unroll
            for (int w = 0; w < 8; ++w) s_ += red[(w * 9 + r) * 64 + c];
            mod[(size_t)(l * 9 + r) * 12288 + cc + c] = s_ + p.in[5][l * 12288 + cc + c]; }
        __syncthreads();
    }
    LAS unsigned* l32 = (LAS unsigned*)lds;
    __syncthreads();
    if ((nblk & 1) == 0 && nblk >= 2) { if (bid >= nblk / 2) xpose_mat(p.in[11], (bf16_t*)(p.ws + WS_WABIN), 2048, 4096, 4096, l32, tid, bid - nblk / 2, nblk / 2); }
    else xpose_mat(p.in[11], (bf16_t*)(p.ws + WS_WABIN), 2048, 4096, 4096, l32, tid, bid, nblk);
}

__device__ __forceinline__ void phase_norm(const float* XL, const float* XC, const float* gvec, const float* modl, int sh_off, int sc_off, bf16_t* H, int nrows, int gw, int nw, int lane, const float* PART = nullptr, const float* pgate = nullptr) {
    for (int row = gw; row < nrows; row += nw) {
        const float* x = row < ML ? XL + (size_t)row * DM : XC + (size_t)(row - ML) * DM;
        const float* mr = modl + (size_t)(row < ML ? (row >> 11) : 8) * 12288;
        f32x4 v[8]; float ss = 0.f;
#pragma unroll
        for (int i = 0; i < 8; ++i) { v[i] = *(const f32x4*)(x + i * 256 + lane * 4);
            if (PART && row >= ML) { const float* pp = PART + (size_t)(row - ML) * DM + i * 256 + lane * 4;
                const f32x4 ps = (*(const f32x4*)pp + *(const f32x4*)(pp + (size_t)MC * DM)) + (*(const f32x4*)(pp + (size_t)2 * MC * DM) + *(const f32x4*)(pp + (size_t)3 * MC * DM));
                v[i] = v[i] + *(const f32x4*)(pgate + i * 256 + lane * 4) * ps; }
            ss += v[i][0] * v[i][0] + v[i][1] * v[i][1] + v[i][2] * v[i][2] + v[i][3] * v[i][3]; }
        ss = wave_sum(ss);
        const float rstd = rsqrtf(ss * (1.f / 2048.f) + 1e-6f);
#pragma unroll
        for (int i = 0; i < 8; ++i) { const int col = i * 256 + lane * 4;
            const f32x4 g = *(const f32x4*)(gvec + col), sc = *(const f32x4*)(mr + sc_off + col), sh = *(const f32x4*)(mr + sh_off + col);
            const f32x4 y = v[i] * rstd * g * (sc + 1.f) + sh;
            u32x2 w; w.x = pk_bf16(y[0], y[1]); w.y = pk_bf16(y[2], y[3]);
            *(u32x2*)(H + (size_t)row * DM + col) = w; }
    }
}
__device__ __forceinline__ void phase_final_norm(float* X, const float* gvec, int gw, int nw, int lane) {
    for (int row = gw; row < ML; row += nw) {
        float* x = X + (size_t)row * DM;
        f32x4 v[8]; float ss = 0.f;
#pragma unroll
        for (int i = 0; i < 8; ++i) { v[i] = *(const f32x4*)(x + i * 256 + lane * 4); ss += v[i][0] * v[i][0] + v[i][1] * v[i][1] + v[i][2] * v[i][2] + v[i][3] * v[i][3]; }
        ss = wave_sum(ss);
        const float rstd = rsqrtf(ss * (1.f / 2048.f) + 1e-6f);
#pragma unroll
        for (int i = 0; i < 8; ++i) { const int col = i * 256 + lane * 4; const f32x4 g = *(const f32x4*)(gvec + col); *(f32x4*)(x + col) = v[i] * rstd * g; }
    }
}

__device__ __forceinline__ void phase_vt0(const Params& p, int tid, int bid, int nblk) {
    const bf16_t* P0 = (const bf16_t*)(p.ws + WS_PROJ0); bf16_t* VT = (bf16_t*)(p.ws + WS_VT0);
    for (int item = bid; item < 576; item += nblk) {
        const int cid = item >> 1, vc = (item & 1) * 512 + tid;
        int b, pos0;
        if (cid < 256) { b = cid >> 5; pos0 = 256 + (cid & 31) * 64; } else { const int cc = cid - 256; b = cc >> 2; pos0 = (cc & 3) * 64; }
        const bf16_t* src = P0 + (size_t)cid * 64 * P0LD + 2048 + vc;
        bf16_t* dst = VT + (((size_t)(b * 8 + (vc >> 7)) * 288 + (pos0 >> 3)) * 128 + (vc & 127)) * 8;
#pragma unroll
        for (int q = 0; q < 8; ++q) { unsigned w[4];
#pragma unroll
            for (int e = 0; e < 4; ++e) { const unsigned lo = src[(size_t)(q * 8 + 2 * e) * P0LD], hi = src[(size_t)(q * 8 + 2 * e + 1) * P0LD]; w[e] = lo | (hi << 16); }
            u32x4 o; o.x = w[0]; o.y = w[1]; o.z = w[2]; o.w = w[3];
            *(u32x4*)(dst + (size_t)q * 1024) = o; }
    }
}

__device__ __forceinline__ void s5_disc(float lr, float li, float dt, float& ar, float& ai, float& f_r, float& f_i) {
    const float mag = expf(lr * dt); float sn, cs; sincosf(li * dt, &sn, &cs);
    ar = mag * cs; ai = mag * sn; const float den = lr * lr + li * li;
    f_r = ((ar - 1.f) * lr + ai * li) / den; f_i = (ai * lr - (ar - 1.f) * li) / den;
}
__device__ __forceinline__ void s5_wave(const Params& p, int sw, LAS unsigned char* wl, int lane) {
    const int b = sw >> 7, g = (sw >> 1) & 63, dir = sw & 1;
    const int fr = lane & 15, fq = lane >> 4;
    const int pg = dir * 64 + g;
    const float* LR = p.in[14] + pg * 64; const float* LI = p.in[15] + pg * 64;
    const float dt = expf(p.in[16][pg]);
    const float* BR = p.in[17] + (size_t)pg * 1024; const float* BI = p.in[18] + (size_t)pg * 1024;
    const float* CR = p.in[19] + (size_t)pg * 1024; const float* CI = p.in[20] + (size_t)pg * 1024;
    float ar, ai; { float t0, t1; s5_disc(LR[lane], LI[lane], dt, ar, ai, t0, t1); }
    bf16x8 bbA[8];
#pragma unroll
    for (int q = 0; q < 8; ++q) {
        const int sg = q * 16 + fr, pp = sg >> 1, part = sg & 1;
        float a_r, a_i, f_r, f_i; s5_disc(LR[pp], LI[pp], dt, a_r, a_i, f_r, f_i);
        u32x4 w = {0u, 0u, 0u, 0u};
        if (fq < 2) {
            const f32x4 br0 = *(const f32x4*)(BR + pp * 16 + fq * 8), br1 = *(const f32x4*)(BR + pp * 16 + fq * 8 + 4);
            const f32x4 bi0 = *(const f32x4*)(BI + pp * 16 + fq * 8), bi1 = *(const f32x4*)(BI + pp * 16 + fq * 8 + 4);
            f32x4 v0, v1;
            if (part == 0) { v0 = br0 * f_r - bi0 * f_i; v1 = br1 * f_r - bi1 * f_i; } else { v0 = bi0 * f_r + br0 * f_i; v1 = bi1 * f_r + br1 * f_i; }
            w.x = pk_bf16(v0[0], v0[1]); w.y = pk_bf16(v0[2], v0[3]); w.z = pk_bf16(v1[0], v1[1]); w.w = pk_bf16(v1[2], v1[3]);
        }
        bbA[q] = __builtin_bit_cast(bf16x8, w);
    }
    bf16x8 cA[4];
#pragma unroll
    for (int kk = 0; kk < 4; ++kk) { const int p0 = kk * 16 + fq * 4;
        const f32x4 cr = *(const f32x4*)(CR + fr * 64 + p0), ci = *(const f32x4*)(CI + fr * 64 + p0);
        u32x4 w; w.x = pk_bf16(cr[0], -ci[0]); w.y = pk_bf16(cr[1], -ci[1]); w.z = pk_bf16(cr[2], -ci[2]); w.w = pk_bf16(cr[3], -ci[3]);
        cA[kk] = __builtin_bit_cast(bf16x8, w); }
    LAS float* BU = (LAS float*)wl;
    LAS unsigned* HH = (LAS unsigned*)(wl + 16 * 132 * 4);
    const bf16_t* P0 = (const bf16_t*)(p.ws + WS_PROJ0);
    bf16_t* YS = (bf16_t*)(p.ws + WS_YS5) + (size_t)dir * MT * 1024;
    float hr = 0.f, hi = 0.f;
    const float a2r = ar * ar - ai * ai, a2i = 2.f * ar * ai;
    const f32x4 z4 = {0.f, 0.f, 0.f, 0.f};
    auto rowof = [&](int ti_) { const int s = ti_ * 16 + fr;
        return dir == 0 ? (s < 256 ? ML + b * 256 + s : b * 2048 + (s - 256)) : (s < 256 ? ML + b * 256 + 255 - s : b * 2048 + 2047 - (s - 256)); };
    int row_n = rowof(0);
    u32x4 uw_n = {0u, 0u, 0u, 0u};
    if (fq < 2) uw_n = *(const u32x4*)(P0 + (size_t)row_n * P0LD + 3072 + g * 16 + fq * 8);
    for (int ti = 0; ti < 144; ++ti) {
        const int row = row_n; const bf16x8 ub = __builtin_bit_cast(bf16x8, uw_n);
        if (ti + 1 < 144) { row_n = rowof(ti + 1); if (fq < 2) uw_n = *(const u32x4*)(P0 + (size_t)row_n * P0LD + 3072 + g * 16 + fq * 8); }
#pragma unroll
        for (int q = 0; q < 8; ++q) { const f32x4 d = MFMA16(bbA[q], ub, z4); *(LAS f32x4*)(BU + fr * 132 + q * 16 + fq * 4) = d; }
        WAVE_LDS_SYNC();
        f32x2 bu[16];
#pragma unroll
        for (int t = 0; t < 16; ++t) bu[t] = *(const LAS f32x2*)(BU + t * 132 + 2 * lane);
        float hre[16], him[16];
        hre[0] = ar * hr - ai * hi + bu[0].x; him[0] = ar * hi + ai * hr + bu[0].y;
        hre[1] = ar * hre[0] - ai * him[0] + bu[1].x; him[1] = ar * him[0] + ai * hre[0] + bu[1].y;
#pragma unroll
        for (int t = 2; t < 16; ++t) { const float cx = ar * bu[t - 1].x - ai * bu[t - 1].y + bu[t].x, cy = ar * bu[t - 1].y + ai * bu[t - 1].x + bu[t].y;
            hre[t] = a2r * hre[t - 2] - a2i * him[t - 2] + cx; him[t] = a2r * him[t - 2] + a2i * hre[t - 2] + cy; }
        hr = hre[15]; hi = him[15];
#pragma unroll
        for (int t = 0; t < 16; ++t) HH[t * 68 + lane] = pk_bf16(hre[t], him[t]);
        WAVE_LDS_SYNC();
        f32x4 y = z4;
#pragma unroll
        for (int kk = 0; kk < 4; ++kk) { const bf16x8 hb = *(const LAS bf16x8*)(HH + fr * 68 + kk * 16 + fq * 4); y = MFMA16(cA[kk], hb, y); }
        u32x2 o; o.x = pk_bf16(y[0], y[1]); o.y = pk_bf16(y[2], y[3]);
        *(u32x2*)(YS + (size_t)row * 1024 + g * 16 + fq * 4) = o;
        WAVE_LDS_SYNC();
    }
}

__device__ __forceinline__ void na_item(const Params& p, int item, int lane, const LAS float* RBL) {
    const bf16_t* P0 = (const bf16_t*)(p.ws + WS_PROJ0); const bf16_t* VT = (const bf16_t*)(p.ws + WS_VT0); bf16_t* MIX = (bf16_t*)(p.ws + WS_MIX);
    const int fr = lane & 15, fq = lane >> 4;
    int b, h, c0 = 0, ks0 = 0, nwin = 0, rsA = 0, rsB = 0, rA = 0, rB = 0, qrowA, qrowB;
    if (item < 4096) { b = item >> 9; const int rem = item & 511; h = rem >> 6; const int pr = rem & 63; rA = (pr >> 2) * 2; rB = rA + 1; c0 = (pr & 3) * 16;
        rsA = min(max(rA - 4, 0), 24); rsB = min(max(rB - 4, 0), 24); nwin = rsB - rsA + 8; ks0 = min(max(c0 - 8, 0), 32);
        qrowA = b * 2048 + rA * 64 + c0 + fr; qrowB = qrowA + 64; }
    else { const int it = item - 4096; b = it >> 6; h = (it >> 3) & 7; qrowA = ML + b * 256 + (it & 7) * 32 + fr; qrowB = qrowA + 16; }
    const int nblkk = 8 + nwin;
    bf16x8 qfA[4], qfB[4];
#pragma unroll
    for (int kk = 0; kk < 4; ++kk) { qfA[kk] = *(const bf16x8*)(P0 + (size_t)qrowA * P0LD + h * 128 + kk * 32 + fq * 8); qfB[kk] = *(const bf16x8*)(P0 + (size_t)qrowB * P0LD + h * 128 + kk * 32 + fq * 8); }
    float mA = -1e30f, lA = 0.f, mB = -1e30f, lB = 0.f;
    f32x4 oA[8], oB[8];
    const f32x4 z4 = {0.f, 0.f, 0.f, 0.f};
#pragma unroll
    for (int dt = 0; dt < 8; ++dt) { oA[dt] = z4; oB[dt] = z4; }
    const int qcol = c0 + fr, wst = min(max(qcol - 8, 0), 48);
    auto krow_of = [&](int blk_) { return blk_ < 8 ? ML + b * 256 + blk_ * 32 : b * 2048 + (rsA + blk_ - 8) * 64 + ks0; };
    const int kperm = (fr >> 2) * 8 + (fr & 3);
    bf16x8 kc0[4], kc1[4];
    { const bf16_t* kp0 = P0 + (size_t)(krow_of(0) + kperm) * P0LD + 1024 + h * 128 + fq * 8;
#pragma unroll
      for (int kk = 0; kk < 4; ++kk) { kc0[kk] = *(const bf16x8*)(kp0 + kk * 32); kc1[kk] = *(const bf16x8*)(kp0 + (size_t)4 * P0LD + kk * 32); } }
    for (int blk = 0; blk < nblkk; ++blk) {
        const int wrow = rsA + blk - 8;
        const int vpos0 = blk < 8 ? blk * 32 : 256 + wrow * 64 + ks0;
        const bf16_t* vp = VT + (((size_t)(b * 8 + h) * 288 + (vpos0 >> 3) + fq) * 128 + fr) * 8;
        u32x4 vv[8];
#pragma unroll
        for (int dt = 0; dt < 8; ++dt) vv[dt] = *(const u32x4*)(vp + dt * 128);
        bf16x8 kn0[4], kn1[4];
        { const int nb = blk + 1 < nblkk ? blk + 1 : blk; const bf16_t* kp0 = P0 + (size_t)(krow_of(nb) + kperm) * P0LD + 1024 + h * 128 + fq * 8;
#pragma unroll
          for (int kk = 0; kk < 4; ++kk) { kn0[kk] = *(const bf16x8*)(kp0 + kk * 32); kn1[kk] = *(const bf16x8*)(kp0 + (size_t)4 * P0LD + kk * 32); } }
        f32x4 a0 = z4, a1 = z4, b0 = z4, b1 = z4;
#pragma unroll
        for (int kk = 0; kk < 4; ++kk) { a0 = MFMA16(kc0[kk], qfA[kk], a0); a1 = MFMA16(kc1[kk], qfA[kk], a1); b0 = MFMA16(kc0[kk], qfB[kk], b0); b1 = MFMA16(kc1[kk], qfB[kk], b1); }
        float sA[8], sB[8];
#pragma unroll
        for (int jj = 0; jj < 4; ++jj) { sA[jj] = a0[jj] * 0.08838834764831845f; sA[4 + jj] = a1[jj] * 0.08838834764831845f; sB[jj] = b0[jj] * 0.08838834764831845f; sB[4 + jj] = b1[jj] * 0.08838834764831845f; }
        if (blk >= 8) {
            const bool actA = wrow >= rsA && wrow < rsA + 8, actB = wrow >= rsB && wrow < rsB + 8;
            const int riA = min(max(wrow - rA + 7, 0), 14), riB = min(max(wrow - rB + 7, 0), 14);
            const LAS float* rbA = RBL + (h * 15 + riA) * 31; const LAS float* rbB = RBL + (h * 15 + riB) * 31;
            float bvA[8], bvB[8];
#pragma unroll
            for (int e = 0; e < 8; ++e) { const int ci = min(max(ks0 + fq * 8 + e - qcol + 15, 0), 30); bvA[e] = rbA[ci]; bvB[e] = rbB[ci]; }
#pragma unroll
            for (int e = 0; e < 8; ++e) { const int kcol = ks0 + fq * 8 + e; const bool ok = kcol >= wst && kcol < wst + 16;
                sA[e] = (ok && actA) ? sA[e] + bvA[e] : -1e30f; sB[e] = (ok && actB) ? sB[e] + bvB[e] : -1e30f; } }
        float bmA = sA[0], bmB = sB[0];
#pragma unroll
        for (int e = 1; e < 8; ++e) { bmA = fmaxf(bmA, sA[e]); bmB = fmaxf(bmB, sB[e]); }
        bmA = fmaxf(bmA, __shfl_xor(bmA, 16)); bmA = fmaxf(bmA, __shfl_xor(bmA, 32)); bmB = fmaxf(bmB, __shfl_xor(bmB, 16)); bmB = fmaxf(bmB, __shfl_xor(bmB, 32));
        const float mnA = fmaxf(mA, bmA), alA = __expf(mA - mnA), mnB = fmaxf(mB, bmB), alB = __expf(mB - mnB);
        float psA = 0.f, psB = 0.f;
#pragma unroll
        for (int e = 0; e < 8; ++e) { sA[e] = __expf(sA[e] - mnA); psA += sA[e]; sB[e] = __expf(sB[e] - mnB); psB += sB[e]; }
        psA += __shfl_xor(psA, 16); psA += __shfl_xor(psA, 32); psB += __shfl_xor(psB, 16); psB += __shfl_xor(psB, 32);
        lA = lA * alA + psA; mA = mnA; lB = lB * alB + psB; mB = mnB;
        u32x4 pwA, pwB;
        pwA.x = pk_bf16(sA[0], sA[1]); pwA.y = pk_bf16(sA[2], sA[3]); pwA.z = pk_bf16(sA[4], sA[5]); pwA.w = pk_bf16(sA[6], sA[7]);
        pwB.x = pk_bf16(sB[0], sB[1]); pwB.y = pk_bf16(sB[2], sB[3]); pwB.z = pk_bf16(sB[4], sB[5]); pwB.w = pk_bf16(sB[6], sB[7]);
        const bf16x8 pfA = __builtin_bit_cast(bf16x8, pwA), pfB = __builtin_bit_cast(bf16x8, pwB);
#pragma unroll
        for (int dt = 0; dt < 8; ++dt) { const bf16x8 vf = __builtin_bit_cast(bf16x8, vv[dt]);
            oA[dt] = oA[dt] * alA; oA[dt] = MFMA16(vf, pfA, oA[dt]); oB[dt] = oB[dt] * alB; oB[dt] = MFMA16(vf, pfB, oB[dt]); }
#pragma unroll
        for (int kk = 0; kk < 4; ++kk) { kc0[kk] = kn0[kk]; kc1[kk] = kn1[kk]; }
    }
    const float invA = 1.f / lA, invB = 1.f / lB;
    bf16_t* opA = MIX + (size_t)qrowA * 2048 + h * 128 + fq * 4; bf16_t* opB = MIX + (size_t)qrowB * 2048 + h * 128 + fq * 4;
#pragma unroll
    for (int dt = 0; dt < 8; ++dt) { u32x2 o; o.x = pk_bf16(oA[dt][0] * invA, oA[dt][1] * invA); o.y = pk_bf16(oA[dt][2] * invA, oA[dt][3] * invA); *(u32x2*)(opA + dt * 16) = o;
        u32x2 o2; o2.x = pk_bf16(oB[dt][0] * invB, oB[dt][1] * invB); o2.y = pk_bf16(oB[dt][2] * invB, oB[dt][3] * invB); *(u32x2*)(opB + dt * 16) = o2; }
}

__device__ __forceinline__ void xpose_wave_tile(const float* __restrict__ src, bf16_t* __restrict__ dst, int K, int N, int kt, int ntile, LAS unsigned* l32, int lane) {
    const int k0 = kt * 64, n0 = ntile * 64; const bool ok = (n0 + lane) < N;
    const float* sp = src + (size_t)k0 * N + n0 + lane;
    { float v[64];
#pragma unroll
        for (int i = 0; i < 64; ++i) v[i] = ok ? sp[(size_t)i * N] : 0.f;
#pragma unroll
        for (int i = 0; i < 32; ++i) l32[lane * 33 + i] = pk_bf16(v[2 * i], v[2 * i + 1]); }
    WAVE_LDS_SYNC();
#pragma unroll
    for (int j = 0; j < 8; ++j) { const int c = j * 64 + lane, row = c >> 3, chn = c & 7;
        u32x4 w; w.x = l32[row * 33 + chn * 4]; w.y = l32[row * 33 + chn * 4 + 1]; w.z = l32[row * 33 + chn * 4 + 2]; w.w = l32[row * 33 + chn * 4 + 3];
        *(u32x4*)(dst + (size_t)(n0 + row) * K + k0 + chn * 8) = w; }
    WAVE_LDS_SYNC();
}
__device__ __forceinline__ void xpose_item(const Params& p, int tile, LAS unsigned* l32, int lane) {
    const float* src; bf16_t* dst; int K, N, nkt;
    if (tile < 1024) { src = p.in[12]; dst = (bf16_t*)(p.ws + WS_WABOUT); K = 2048; N = 2048; nkt = 32; }
    else if (tile < 1280) { tile -= 1024; src = p.in[22]; dst = (bf16_t*)(p.ws + WS_WGLU); K = 1024; N = 1024; nkt = 16; }
    else if (tile < 5376) { tile -= 1280; src = p.in[8]; dst = (bf16_t*)(p.ws + WS_W1); K = 2048; N = 8192; nkt = 32; }
    else if (tile < 9472) { tile -= 5376; src = p.in[8] + (size_t)2048 * 8192; dst = (bf16_t*)(p.ws + WS_W1) + (size_t)8192 * 2048; K = 2048; N = 8192; nkt = 32; }
    else if (tile < 13568) { tile -= 9472; src = p.in[9]; dst = (bf16_t*)(p.ws + WS_W2); K = 8192; N = 2048; nkt = 128; }
    else if (tile < 17664) { tile -= 13568; src = p.in[9] + (size_t)8192 * 2048; dst = (bf16_t*)(p.ws + WS_W2) + (size_t)2048 * 8192; K = 8192; N = 2048; nkt = 128; }
    else if (tile < 20864) { tile -= 17664; src = p.in[24]; dst = (bf16_t*)(p.ws + WS_WGIN); K = 2048; N = 6176; nkt = 32; }
    else { tile -= 20864; src = p.in[28]; dst = (bf16_t*)(p.ws + WS_WGOUT); K = 2048; N = 2048; nkt = 32; }
    xpose_wave_tile(src, dst, K, N, tile % nkt, tile / nkt, l32, lane);
}

__device__ __forceinline__ void phase_mix0(const Params& p, LAS unsigned char* lds, int tid, int bid, int nblk) {
    const int wid = tid >> 6, lane = tid & 63;
    LAS float* RBL = (LAS float*)(lds + 51200);
    LAS unsigned* XL32 = (LAS unsigned*)(lds + 66560 + wid * 8448);
    for (int i = tid; i < 8 * 15 * 31; i += 512) RBL[i] = p.in[13][i];
    __syncthreads();
    if (wid < 4) { for (int sw = bid * 4 + wid; sw < 1024; sw += nblk * 4) s5_wave(p, sw, lds + wid * 12800, lane); }
    unsigned* ctr = (unsigned*)p.ws + 16;
    for (;;) { unsigned it = 0; if (lane == 0) it = atomicAdd(ctr, 1u); it = __builtin_amdgcn_readfirstlane(it); if (it >= 4608u + 2736u) break;
        if (it < 5472u) { if (it & 1u) { const int t0 = (int)(it >> 1) * 8; for (int j = 0; j < 8; ++j) xpose_item(p, t0 + j, XL32, lane); } else na_item(p, (int)(it >> 1), lane, RBL); }
        else na_item(p, (int)(it - 2736u), lane, RBL); }
}

__device__ __forceinline__ void phase_s5fin(const Params& p, int gt, int nt) {
    const bf16_t* P0 = (const bf16_t*)(p.ws + WS_PROJ0); const bf16_t* YF = (const bf16_t*)(p.ws + WS_YS5); const bf16_t* YB = YF + (size_t)MT * 1024;
    bf16_t* GL = (bf16_t*)(p.ws + WS_GL); const float* Dk = p.in[21];
    for (int i = gt; i < MT * 128; i += nt) { const int row = i >> 7, c8 = (i & 127) * 8;
        const u32x4 u = *(const u32x4*)(P0 + (size_t)row * P0LD + 3072 + c8), yf = *(const u32x4*)(YF + (size_t)row * 1024 + c8), yb = *(const u32x4*)(YB + (size_t)row * 1024 + c8);
        const f32x4 d0 = *(const f32x4*)(Dk + c8), d1 = *(const f32x4*)(Dk + c8 + 4);
        float v[8] = {bf_lo(yf.x) + bf_lo(yb.x) + d0[0] * bf_lo(u.x), bf_hi(yf.x) + bf_hi(yb.x) + d0[1] * bf_hi(u.x), bf_lo(yf.y) + bf_lo(yb.y) + d0[2] * bf_lo(u.y), bf_hi(yf.y) + bf_hi(yb.y) + d0[3] * bf_hi(u.y),
                      bf_lo(yf.z) + bf_lo(yb.z) + d1[0] * bf_lo(u.z), bf_hi(yf.z) + bf_hi(yb.z) + d1[1] * bf_hi(u.z), bf_lo(yf.w) + bf_lo(yb.w) + d1[2] * bf_lo(u.w), bf_hi(yf.w) + bf_hi(yb.w) + d1[3] * bf_hi(u.w)};
#pragma unroll
        for (int e = 0; e < 8; ++e) { const float x = v[e], t = __builtin_amdgcn_rcpf(fabsf(x) * 0.2316418882f + 1.0f);
            float q = t * 0.5307027145f + (-0.7265760135f); q = q * t + 0.7107068705f; q = q * t + (-0.142248368f); q = q * t + 0.127414796f; q = q * t;
            const float m = x * (q * __builtin_amdgcn_exp2f((x * x) * (-0.72134752044f))); v[e] = x < 0.f ? m : x - m; }
        u32x4 w; w.x = pk_bf16(v[0], v[1]); w.y = pk_bf16(v[2], v[3]); w.z = pk_bf16(v[4], v[5]); w.w = pk_bf16(v[6], v[7]);
        *(u32x4*)(GL + (size_t)row * 1024 + c8) = w; }
}

__device__ __forceinline__ void phase_glaprep(const Params& p, LAS unsigned char* lds, int tid, int bid, int nblk) {
    const bf16_t* QK = (const bf16_t*)(p.ws + WS_QK); const bf16_t* V1 = (const bf16_t*)(p.ws + WS_V1); const bf16_t* A1 = (const bf16_t*)(p.ws + WS_A1);
    bf16_t* QIN = (bf16_t*)(p.ws + WS_QIN); bf16_t* KIN = (bf16_t*)(p.ws + WS_KIN); bf16_t* KENDT = (bf16_t*)(p.ws + WS_KENDT); bf16_t* VT1 = (bf16_t*)(p.ws + WS_VT1);
    float* DEC = (float*)(p.ws + WS_DEC);
    LAS float* AC = (LAS float*)lds;
    LAS bf16_t* KE = (LAS bf16_t*)(lds + 8192);
    LAS bf16_t* QL = (LAS bf16_t*)(lds + 8192 + 67584);
    LAS bf16_t* KL = QL + 64 * 264;
    LAS float* HS = (LAS float*)(lds + 143360);
    for (int item = bid; item < 1152; item += nblk) {
        const int cid = item >> 2, h = item & 3; const int row0 = cid * 64; const bool lat = cid < 256;
        __syncthreads();
        { const int t = tid >> 3, c4 = (tid & 7) * 4; const u32x2 a = *(const u32x2*)(A1 + (size_t)(row0 + t) * 256 + c4);
          AC[t * 32 + c4] = bf_lo(a.x); AC[t * 32 + c4 + 1] = bf_hi(a.x); AC[t * 32 + c4 + 2] = bf_lo(a.y); AC[t * 32 + c4 + 3] = bf_hi(a.y); }
#pragma unroll
        for (int i = 0; i < 4; ++i) { const int piece = tid + i * 512, r = piece >> 5, c16 = piece & 31;
            const bf16_t* src = QK + (size_t)(row0 + r) * 2048 + h * 256 + c16 * 8;
            *(LAS u32x4*)(QL + r * 264 + c16 * 8) = *(const u32x4*)src;
            *(LAS u32x4*)(KL + r * 264 + c16 * 8) = *(const u32x4*)(src + 1024); }
        { const bf16_t* src = V1 + (size_t)row0 * 2048 + h * 512 + tid; LAS unsigned* vrow = (LAS unsigned*)(KE + tid * 66);
#pragma unroll
          for (int q = 0; q < 8; ++q) {
#pragma unroll
              for (int e = 0; e < 4; ++e) { const unsigned lo = src[(size_t)(q * 8 + 2 * e) * 2048], hi = src[(size_t)(q * 8 + 2 * e + 1) * 2048]; vrow[q * 4 + e] = lo | (hi << 16); } } }
        __syncthreads();
        { const int wv_ = tid >> 6, ln_ = tid & 63; bf16_t* dstb = VT1 + (size_t)(cid * 4 + h) * 512 * 64;
#pragma unroll
          for (int j = 0; j < 8; ++j) { const int row = wv_ * 64 + j * 8 + (ln_ >> 3), chn = ln_ & 7; const LAS unsigned* kr = (const LAS unsigned*)(KE + row * 66) + chn * 4;
              u32x4 o; o.x = kr[0]; o.y = kr[1]; o.z = kr[2]; o.w = kr[3]; *(u32x4*)(dstb + (size_t)row * 64 + chn * 8) = o; } }
        __syncthreads();
        const int dir = tid >> 8, th = (tid >> 7) & 1, dk0 = (tid & 127) * 2, ch = h * 256 + dk0, t0 = th * 32;
        float wa[16], wb[16];
#pragma unroll
        for (int r = 0; r < 16; ++r) { const f32x2 w2 = *(const f32x2*)(p.in[25] + (size_t)(dir * 16 + r) * 1024 + ch); wa[r] = w2.x; wb[r] = w2.y; }
        const f32x2 ba2 = *(const f32x2*)(p.in[26] + dir * 1024 + ch);
        LAS bf16_t* kela = KE + (dir * 256 + dk0) * 66 + t0;
        LAS bf16_t* kelb = kela + 66;
        float hs0 = 0.f, hs1 = 0.f;
#pragma unroll 4
        for (int tt = 0; tt < 32; ++tt) { const int t = t0 + tt; float z0 = ba2.x, z1 = ba2.y;
#pragma unroll
            for (int r4 = 0; r4 < 4; ++r4) { const f32x4 a = *(const LAS f32x4*)(AC + t * 32 + dir * 16 + r4 * 4);
                z0 += a[0] * wa[r4 * 4] + a[1] * wa[r4 * 4 + 1] + a[2] * wa[r4 * 4 + 2] + a[3] * wa[r4 * 4 + 3];
                z1 += a[0] * wb[r4 * 4] + a[1] * wb[r4 * 4 + 1] + a[2] * wb[r4 * 4 + 2] + a[3] * wb[r4 * 4 + 3]; }
            const _Float16 l0 = (_Float16)((fminf(z0, 0.f) - __logf(1.f + __expf(-fabsf(z0)))) * (1.f / 16.f));
            const _Float16 l1 = (_Float16)((fminf(z1, 0.f) - __logf(1.f + __expf(-fabsf(z1)))) * (1.f / 16.f));
            kela[tt] = __builtin_bit_cast(unsigned short, l0); kelb[tt] = __builtin_bit_cast(unsigned short, l1); hs0 += (float)l0; hs1 += (float)l1; }
        HS[tid * 2] = hs0; HS[tid * 2 + 1] = hs1;
        __syncthreads();
        const f32x2 oth = *(const LAS f32x2*)(HS + (tid ^ 128) * 2);
        const float blast0 = hs0 + oth.x, blast1 = hs1 + oth.y;
        const float eb0 = __expf(blast0), eb1 = __expf(blast1);
        if (th == 0) *(f32x2*)(DEC + (size_t)((dir * 288 + cid) * 4 + h) * 256 + dk0) = (f32x2){eb0, eb1};
        const int fi = dk0 & 63, halfsel = dk0 >> 7; const bool lowpart = (dk0 & 64) == 0;
        const float fr0 = exp2f(-(float)fi * (13.287712379549449f / 64.f)), fr1 = exp2f(-(float)(fi + 1) * (13.287712379549449f / 64.f));
        float cr0 = 1.f, sr0 = 0.f, cr1 = 1.f, sr1 = 0.f;
        if (lat) { const float rp = (float)(cid & 31); sr0 = __sinf(rp * fr0); cr0 = __cosf(rp * fr0); sr1 = __sinf(rp * fr1); cr1 = __cosf(rp * fr1); }
        bf16_t* qo = QIN + ((size_t)dir * MT + row0) * 1024 + ch; bf16_t* ko = KIN + ((size_t)dir * MT + row0) * 1024 + ch;
        float run0 = th ? oth.x : 0.f, run1 = th ? oth.y : 0.f;
        float cc0 = __cosf((float)t0 * fr0), sc0 = __sinf((float)t0 * fr0), cc1 = __cosf((float)t0 * fr1), sc1 = __sinf((float)t0 * fr1);
        const float cd0 = __cosf(fr0), sd0 = __sinf(fr0), cd1 = __cosf(fr1), sd1 = __sinf(fr1);
#pragma unroll 4
        for (int tt = 0; tt < 32; ++tt) { const int t = t0 + tt;
            const float la0 = (float)__builtin_bit_cast(_Float16, (unsigned short)kela[tt]), la1 = (float)__builtin_bit_cast(_Float16, (unsigned short)kelb[tt]);
            const float bc0 = dir ? (blast0 - run0) : (run0 + la0), bc1 = dir ? (blast1 - run1) : (run1 + la1);
            run0 += la0; run1 += la1;
            const unsigned qw = *(const LAS unsigned*)(QL + t * 264 + dk0), kw = *(const LAS unsigned*)(KL + t * 264 + dk0);
            float q0 = lat ? bf_lo(qw) * 0.0625f : 0.f, q1 = lat ? bf_hi(qw) * 0.0625f : 0.f, k0 = bf_lo(kw), k1 = bf_hi(kw);
            if (lat) { const unsigned qpw = *(const LAS unsigned*)(QL + t * 264 + (dk0 ^ 64)), kpw = *(const LAS unsigned*)(KL + t * 264 + (dk0 ^ 64));
                const float q2a = bf_lo(qpw) * 0.0625f, q2b = bf_hi(qpw) * 0.0625f, k2a = bf_lo(kpw), k2b = bf_hi(kpw);
                float c0 = cr0, s0 = sr0, c1 = cr1, s1 = sr1;
                if (halfsel) { s0 = sc0; c0 = cc0; s1 = sc1; c1 = cc1; }
                if (lowpart) { q0 = q0 * c0 - q2a * s0; k0 = k0 * c0 - k2a * s0; q1 = q1 * c1 - q2b * s1; k1 = k1 * c1 - k2b * s1; }
                else { q0 = q0 * c0 + q2a * s0; k0 = k0 * c0 + k2a * s0; q1 = q1 * c1 + q2b * s1; k1 = k1 * c1 + k2b * s1; } }
            const float e0 = __expf(bc0), e1 = __expf(bc1), ie0 = __builtin_amdgcn_rcpf(e0), ie1 = __builtin_amdgcn_rcpf(e1);
            const float ki0 = k0 * ie0, ki1 = k1 * ie1;
            *(unsigned*)(qo + (size_t)t * 1024) = pk_bf16(q0 * e0, q1 * e1);
            *(unsigned*)(ko + (size_t)t * 1024) = pk_bf16(ki0, ki1);
            const unsigned kew = pk_bf16(ki0 * eb0, ki1 * eb1);
            kela[tt] = (bf16_t)(kew & 0xffffu); kelb[tt] = (bf16_t)(kew >> 16);
            { const float nc0 = cc0 * cd0 - sc0 * sd0, ns0 = sc0 * cd0 + cc0 * sd0, nc1 = cc1 * cd1 - sc1 * sd1, ns1 = sc1 * cd1 + cc1 * sd1; cc0 = nc0; sc0 = ns0; cc1 = nc1; sc1 = ns1; }
        }
        __syncthreads();
        {
            const int wv_ = tid >> 6, ln_ = tid & 63;
#pragma unroll
            for (int j = 0; j < 8; ++j) { const int row = wv_ * 64 + j * 8 + (ln_ >> 3), chn = ln_ & 7; const LAS unsigned* kr = (const LAS unsigned*)(KE + row * 66) + chn * 4;
                bf16_t* keo = KENDT + ((size_t)(((row >> 8) * 288 + cid) * 4 + h) * 256 + (row & 255)) * 64 + chn * 8;
                u32x4 o; o.x = kr[0]; o.y = kr[1]; o.z = kr[2]; o.w = kr[3]; *(u32x4*)keo = o; } }
    }
}

__device__ __forceinline__ void phase_glascan(const Params& p, LAS unsigned char* lds, int tid, int bid, int nblk) {
    const bf16_t* QIN = (const bf16_t*)(p.ws + WS_QIN); const bf16_t* KIN = (const bf16_t*)(p.ws + WS_KIN); const bf16_t* KENDT = (const bf16_t*)(p.ws + WS_KENDT);
    const bf16_t* VT1 = (const bf16_t*)(p.ws + WS_VT1); const float* DEC = (const float*)(p.ws + WS_DEC);
    const int wid = tid >> 6, lane = tid & 63, fr = lane & 15, fq = lane >> 4;
    LAS unsigned char* QL = lds;
    LAS unsigned char* KL = lds + 33792;
    LAS unsigned char* EL = lds + 67584;
    LAS unsigned char* AL = lds + 104448;
    LAS float* DL = (LAS float*)(lds + 113664);
    const f32x4 z4 = {0.f, 0.f, 0.f, 0.f};
    for (int item = bid; item < 256; item += nblk) {
        const int xg = item & 7, ig = item >> 3, grp = (ig >> 2) * 8 + xg;
        const int seq = grp >> 1, dir = grp & 1, dvs = ig & 3, b = seq >> 2, h = seq & 3;
        const int dv0 = dvs * 128 + wid * 16;
        bf16_t* OFB = (bf16_t*)(p.ws + (dir ? WS_V1 : WS_QK));
        f32x4 S[16];
#pragma unroll
        for (int kt = 0; kt < 16; ++kt) S[kt] = z4;
        auto cid_of = [&](int n_) { const bool lt = n_ >= 4; return dir == 0 ? (lt ? b * 32 + (n_ - 4) : 256 + b * 4 + n_) : (lt ? b * 32 + 31 - (n_ - 4) : 256 + b * 4 + 3 - n_); };
        u32x4 rq[4], rk[4], re[4]; float rd = 0.f; bf16x8 rv[2];
        auto fetch = [&](int n_) { const int cid_ = cid_of(n_); const int row0_ = cid_ * 64; const size_t cb_ = (size_t)((dir * 288 + cid_) * 4 + h);
            if (n_ >= 4) {
#pragma unroll
                for (int i = 0; i < 4; ++i) { const int piece = tid + i * 512, r = piece >> 5, c16 = piece & 31;
                    const size_t go = ((size_t)dir * MT + row0_ + r) * 1024 + h * 256 + c16 * 8;
                    rq[i] = *(const u32x4*)(QIN + go); rk[i] = *(const u32x4*)(KIN + go); } }
#pragma unroll
            for (int i = 0; i < 4; ++i) { const int piece = tid + i * 512, r = piece >> 3, c16 = piece & 7;
                re[i] = *(const u32x4*)(KENDT + (cb_ * 256 + r) * 64 + c16 * 8); }
            if (tid < 256) rd = DEC[cb_ * 256 + tid];
#pragma unroll
            for (int ts = 0; ts < 2; ++ts) rv[ts] = *(const bf16x8*)(VT1 + ((size_t)(cid_ * 4 + h) * 512 + dv0 + fr) * 64 + ts * 32 + fq * 8); };
        fetch(0);
        for (int n = 0; n < 36; ++n) {
            const bool lat = n >= 4;
            const int cid = cid_of(n);
            const int row0 = cid * 64;
            __syncthreads();
            if (lat) {
#pragma unroll
                for (int i = 0; i < 4; ++i) { const int piece = tid + i * 512, r = piece >> 5, c16 = piece & 31;
                    *(LAS u32x4*)(QL + r * 528 + c16 * 16) = rq[i]; *(LAS u32x4*)(KL + r * 528 + c16 * 16) = rk[i]; }
            }
#pragma unroll
            for (int i = 0; i < 4; ++i) { const int piece = tid + i * 512, r = piece >> 3, c16 = piece & 7; *(LAS u32x4*)(EL + r * 144 + c16 * 16) = re[i]; }
            if (tid < 256) DL[tid] = rd;
            bf16x8 vf[2]; vf[0] = rv[0]; vf[1] = rv[1];
            __syncthreads();
            if (n + 1 < 36) fetch(n + 1);
            if (lat) {
                const int tit = wid >> 1;
#pragma unroll
                for (int jj2 = 0; jj2 < 2; ++jj2) { const int jt = 2 * (wid & 1) + jj2;
                    const bool need = dir == 0 ? (jt <= tit) : (jt >= tit);
                    f32x4 a = z4;
                    if (need) {
#pragma unroll
                        for (int kk = 0; kk < 8; ++kk) { const bf16x8 kf = *(const LAS bf16x8*)(KL + (jt * 16 + fr) * 528 + (kk * 32 + fq * 8) * 2), qf = *(const LAS bf16x8*)(QL + (tit * 16 + fr) * 528 + (kk * 32 + fq * 8) * 2);
                            a = MFMA16(kf, qf, a); }
                        const int ti = tit * 16 + fr;
#pragma unroll
                        for (int e = 0; e < 4; ++e) { const int tj = jt * 16 + fq * 4 + e; const bool keep = dir == 0 ? (tj <= ti) : (tj >= ti); a[e] = keep ? a[e] : 0.f; }
                    }
                    u32x2 w; w.x = pk_bf16(a[0], a[1]); w.y = pk_bf16(a[2], a[3]);
                    *(LAS u32x2*)(AL + (tit * 16 + fr) * 144 + (jt * 16 + fq * 4) * 2) = w; }
                f32x4 O[4] = {z4, z4, z4, z4};
#pragma unroll
                for (int kp = 0; kp < 8; ++kp) { u32x4 sw; sw.x = pk_bf16(S[2 * kp][0], S[2 * kp][1]); sw.y = pk_bf16(S[2 * kp][2], S[2 * kp][3]); sw.z = pk_bf16(S[2 * kp + 1][0], S[2 * kp + 1][1]); sw.w = pk_bf16(S[2 * kp + 1][2], S[2 * kp + 1][3]);
                    const bf16x8 sA = __builtin_bit_cast(bf16x8, sw);
#pragma unroll
                    for (int tt = 0; tt < 4; ++tt) { const u32x2 lo = *(const LAS u32x2*)(QL + (tt * 16 + fr) * 528 + (kp * 32 + fq * 4) * 2), hi = *(const LAS u32x2*)(QL + (tt * 16 + fr) * 528 + (kp * 32 + 16 + fq * 4) * 2);
                        u32x4 qw; qw.x = lo.x; qw.y = lo.y; qw.z = hi.x; qw.w = hi.y;
                        O[tt] = MFMA16(sA, __builtin_bit_cast(bf16x8, qw), O[tt]); } }
                __syncthreads();
#pragma unroll
                for (int tt = 0; tt < 4; ++tt) {
#pragma unroll
                    for (int ts = 0; ts < 2; ++ts) { const bf16x8 ab = *(const LAS bf16x8*)(AL + (tt * 16 + fr) * 144 + (ts * 32 + fq * 8) * 2); O[tt] = MFMA16(vf[ts], ab, O[tt]); }
                    u32x2 o; o.x = pk_bf16(O[tt][0], O[tt][1]); o.y = pk_bf16(O[tt][2], O[tt][3]);
                    *(u32x2*)(OFB + (size_t)(row0 + tt * 16 + fr) * 2048 + h * 512 + dv0 + fq * 4) = o; }
            }
#pragma unroll
            for (int kt = 0; kt < 16; ++kt) { const f32x4 d4 = *(const LAS f32x4*)(DL + kt * 16 + fq * 4); S[kt] = S[kt] * d4;
#pragma unroll
                for (int ts = 0; ts < 2; ++ts) { const bf16x8 kf = *(const LAS bf16x8*)(EL + (kt * 16 + fr) * 144 + (ts * 32 + fq * 8) * 2); S[kt] = MFMA16(kf, vf[ts], S[kt]); } }
        }
    }
}

__device__ __forceinline__ void phase_glafin(const Params& p, int gw, int nw, int lane) {
    const bf16_t* OF = (const bf16_t*)(p.ws + WS_QK); const bf16_t* OB = (const bf16_t*)(p.ws + WS_V1); const bf16_t* G1 = (const bf16_t*)(p.ws + WS_G1);
    bf16_t* MIX = (bf16_t*)(p.ws + WS_MIX); const float* NG = p.in[27];
    for (int it = gw; it < ML * 4; it += nw) { const int row = it >> 2, h = it & 3; const size_t off = (size_t)row * 2048 + h * 512 + lane * 8;
        const u32x4 a = *(const u32x4*)(OF + off), bb = *(const u32x4*)(OB + off), g = *(const u32x4*)(G1 + off);
        float o[8] = {bf_lo(a.x) + bf_lo(bb.x), bf_hi(a.x) + bf_hi(bb.x), bf_lo(a.y) + bf_lo(bb.y), bf_hi(a.y) + bf_hi(bb.y), bf_lo(a.z) + bf_lo(bb.z), bf_hi(a.z) + bf_hi(bb.z), bf_lo(a.w) + bf_lo(bb.w), bf_hi(a.w) + bf_hi(bb.w)};
        float gg[8] = {bf_lo(g.x), bf_hi(g.x), bf_lo(g.y), bf_hi(g.y), bf_lo(g.z), bf_hi(g.z), bf_lo(g.w), bf_hi(g.w)};
        float ss = 0.f;
#pragma unroll
        for (int e = 0; e < 8; ++e) ss += o[e] * o[e];
        ss = wave_sum(ss);
        const float rstd = rsqrtf(ss * (1.f / 512.f) + 1e-6f);
        const f32x4 n0 = *(const f32x4*)(NG + lane * 8), n1 = *(const f32x4*)(NG + lane * 8 + 4);
        float r[8];
#pragma unroll
        for (int e = 0; e < 8; ++e) { const float ng = e < 4 ? n0[e & 3] : n1[e & 3]; r[e] = o[e] * rstd * ng * (gg[e] / (1.f + __expf(-gg[e]))); }
        u32x4 w; w.x = pk_bf16(r[0], r[1]); w.y = pk_bf16(r[2], r[3]); w.z = pk_bf16(r[4], r[5]); w.w = pk_bf16(r[6], r[7]);
        *(u32x4*)(MIX + off) = w; }
}


#define XB_TMO      128
#define XB_XCNT(j)  (256  + 64 * (j))
#define XB_XSUB(j)  (1280 + 64 * (j))
#define XB_XGEN(j)  (2304 + 64 * (j))
#define XB_TOP      3328
#define XB_TOPGEN   3392
#define XCD_BAR_WORDS 3456
#define XB_SPIN_CAP (1u << 18)

__device__ __forceinline__ unsigned xb_ld(unsigned* p)              { return __hip_atomic_load(p, __ATOMIC_RELAXED, __HIP_MEMORY_SCOPE_AGENT); }
__device__ __forceinline__ unsigned xb_add(unsigned* p, unsigned v) { return __hip_atomic_fetch_add(p, v, __ATOMIC_RELAXED, __HIP_MEMORY_SCOPE_AGENT); }
__device__ __forceinline__ unsigned xb_xcc_id() { return (unsigned)__builtin_amdgcn_s_getreg((3 << 11) | 20) & 0xFu; }
#define XB_SPIN(cond, bar) do { unsigned _sp = 0; while (cond) { __builtin_amdgcn_s_sleep(1); \
    if ((++_sp & 255u) == 0u) { if (xb_ld(&(bar)[XB_TMO])) break; if (_sp > XB_SPIN_CAP) { atomicAdd(&(bar)[XB_TMO], 1u); break; } } } } while (0)

struct XcdBarrier {
    unsigned* bar; unsigned x;
    volatile LAS unsigned* st;
};

__device__ __forceinline__ XcdBarrier xcd_barrier_post(unsigned* bar, volatile LAS unsigned* st) {
    XcdBarrier b; b.bar = bar; b.x = xb_xcc_id(); b.st = st;
    if (threadIdx.x == 0) (void)xb_add(&bar[XB_XCNT(b.x)], 1u);
    return b;
}
__device__ __forceinline__ void xcd_barrier_complete(unsigned* bar, unsigned x, unsigned& nloc, unsigned& nx) {
    const unsigned G = gridDim.x * gridDim.y * gridDim.z;
    unsigned sum, cnt, mine, sp = 0u;
    for (;;) {
        sum = 0u; cnt = 0u; mine = 0u;
#pragma unroll
        for (unsigned j = 0; j < 16; ++j) { const unsigned c = xb_ld(&bar[XB_XCNT(j)]); sum += c; cnt += (c > 0u) ? 1u : 0u; mine = (j == x) ? c : mine; }
        if (sum == G) break;
        __builtin_amdgcn_s_sleep(1);
        if ((++sp & 255u) == 0u) { if (xb_ld(&bar[XB_TMO])) break; if (sp > XB_SPIN_CAP) { atomicAdd(&bar[XB_TMO], 1u); break; } }
    }
    nloc = mine > 0u ? mine : 1u; nx = cnt > 0u ? cnt : 1u;
}

__device__ __forceinline__ void xcd_barrier(const XcdBarrier& b) {
    asm volatile("s_waitcnt vmcnt(0)" ::: "memory");
    __syncthreads();
    if (threadIdx.x == 0) {
        unsigned* bar = b.bar;
        __builtin_amdgcn_s_waitcnt(0);
        unsigned nloc = b.st[0], nx = b.st[1];
        if (nloc == 0u) { xcd_barrier_complete(bar, b.x, nloc, nx); b.st[0] = nloc; b.st[1] = nx; }
        const unsigned old = xb_add(&bar[XB_XSUB(b.x)], 1u);
        const unsigned gen = old / nloc;
        if (old + 1u == (gen + 1u) * nloc) {
            __builtin_amdgcn_fence(__ATOMIC_RELEASE, "agent");
            asm volatile("s_waitcnt vmcnt(0)" ::: "memory");
            const unsigned og = xb_add(&bar[XB_TOP], 1u);
            const unsigned tg = og / nx;
            if (og + 1u == (tg + 1u) * nx) xb_add(&bar[XB_TOPGEN], 1u);
            else XB_SPIN(xb_ld(&bar[XB_TOPGEN]) == tg, bar);
            __builtin_amdgcn_fence(__ATOMIC_ACQUIRE, "agent");
            xb_add(&bar[XB_XGEN(b.x)], 1u);
            asm volatile("s_waitcnt vmcnt(0)" ::: "memory");
        } else {
            XB_SPIN(xb_ld(&bar[XB_XGEN(b.x)]) == gen, bar);
            __builtin_amdgcn_fence(__ATOMIC_ACQUIRE, "agent");
            asm volatile("s_waitcnt vmcnt(0)" ::: "memory");
        }
    }
    __syncthreads();
}

__global__ void __launch_bounds__(512, 2) fwd_mega(Params p) {
    extern __shared__ __attribute__((aligned(16))) unsigned char smem[];
    LAS unsigned char* lds = (LAS unsigned char*)smem;
    cg::grid_group grid = cg::this_grid();
    const int tid = threadIdx.x, bid = blockIdx.x, nblk = gridDim.x, wid = tid >> 6, lane = tid & 63;
    const int gw = bid * 8 + wid, nw = nblk * 8;
    unsigned char* ws = p.ws;
    float* mod = (float*)(ws + WS_MOD);
    float* XL = p.out; float* XC = (float*)(ws + WS_XC);
    bf16_t* H = (bf16_t*)(ws + WS_H); bf16_t* MIX = (bf16_t*)(ws + WS_MIX);
#define RUN(k) (p.ph_lo <= (k) && (k) < p.ph_hi)
#define SYNC(k) do { if (p.ph_lo <= (k) && (k) + 1 < p.ph_hi) xcd_barrier(xbar); } while (0)
#define GEMM_BF16(k, Aop, Bop, Mv, Nv, Kv, EB) do { if (RUN(k)) { const pg8::Gemm g{(Aop), (Bop), (Mv), (Nv), (Kv), 0}; pg8::StaticOrder S; S.init(g.M, g.N, nblk, bid); __syncthreads(); \
        pg8::gemm_phase<EpiBf16S, pg8::StaticOrder, true, true>(lds, g, S, (EB)); } SYNC(k); } while (0)
#define GEMM_RES(k, Aop, Bop, Mv, Nv, Kv, ER) do { if (RUN(k)) { const pg8::Gemm g{(Aop), (Bop), (Mv), (Nv), (Kv), 0}; pg8::StaticOrder S; S.init(g.M, g.N, nblk, bid); __syncthreads(); \
        pg8::gemm_phase<EpiResid, pg8::StaticOrder, false, true>(lds, g, S, (ER)); } SYNC(k); } while (0)
    volatile LAS unsigned* xst = (volatile LAS unsigned*)(lds + LDS_BYTES - 16);
    if (tid == 0) { xst[0] = 0u; xst[1] = 0u; }
    __syncthreads();
    XcdBarrier xbar = xcd_barrier_post((unsigned*)(ws + 4096), xst);
    if (p.ph_lo < 0) grid.sync();
    if (RUN(0)) phase_prep(p, lds, tid, bid, nblk);
    SYNC(0);
    if (RUN(1)) phase_norm(p.in[0], p.in[2], p.in[6], mod, 0, 2048, H, MT, gw, nw, lane);
    SYNC(1);
    GEMM_BF16(2, H, (const bf16_t*)(ws + WS_WABIN), MT, 4096, 2048, (EpiBf16S{(bf16_t*)(ws + WS_PROJ0), nullptr, nullptr, nullptr, P0LD, 0, 1 << 30, 0}));
    if (RUN(3)) phase_vt0(p, tid, bid, nblk);
    SYNC(3);
    if (RUN(4)) phase_mix0(p, lds, tid, bid, nblk);
    SYNC(4);
    if (RUN(5)) phase_s5fin(p, bid * 512 + tid, nblk * 512);
    SYNC(5);
    if (RUN(6)) { const pg8::Gemm g{(const bf16_t*)(ws + WS_GL), (const bf16_t*)(ws + WS_WGLU), MT, 1024, 1024, 0}; pg8::StaticOrder S; S.init(g.M, g.N, nblk, bid); __syncthreads();
        EpiGlu eg{(const bf16_t*)(ws + WS_GL), p.in[23], MIX}; pg8::gemm_phase<EpiGlu, pg8::StaticOrder, true, true>(lds, g, S, eg); }
    SYNC(6);
    GEMM_RES(7, MIX, (const bf16_t*)(ws + WS_WABOUT), MT, 2048, 2048, (EpiResid{p.in[0], p.in[2], XL, XC, mod + 4096}));
    if (RUN(8)) phase_norm(XL, XC, p.in[7], mod, 6144, 8192, H, MT, gw, nw, lane);
    SYNC(8);
    GEMM_BF16(9, H, (const bf16_t*)(ws + WS_W1), MT, 8192, 2048, (EpiBf16S{(bf16_t*)(ws + WS_HID), nullptr, nullptr, nullptr, 8192, 0, 1 << 30, 1}));
    if (RUN(10)) { { const pg8::Gemm g{(const bf16_t*)(ws + WS_HID), (const bf16_t*)(ws + WS_W2), ML, 2048, 8192, 0}; pg8::StaticOrder S; S.init(g.M, g.N, nblk, bid); __syncthreads();
          pg8::gemm_phase<EpiResid, pg8::StaticOrder, false, true>(lds, g, S, (EpiResid{XL, XC, XL, XC, mod + 10240})); }
        { const pg8::Gemm g{(const bf16_t*)(ws + WS_HID), (const bf16_t*)(ws + WS_W2), MT, 2048, 8192, 2048}; SplitOrder S{nblk, bid}; __syncthreads();
          pg8::gemm_phase<EpiPart, SplitOrder, true, true>(lds, g, S, (EpiPart{(float*)(ws + WS_PART)})); } }
    SYNC(10);
    if (RUN(11)) phase_norm(XL, XC, p.in[6] + 2048, mod + 9 * 12288, 0, 2048, H, MT, gw, nw, lane, (const float*)(ws + WS_PART), mod + 8 * 12288 + 10240);
    SYNC(11);
    if (RUN(12)) { const pg8::Gemm g{H, (const bf16_t*)(ws + WS_WGIN), MT, 6400, 2048, 0}; Proj1Order S; S.init(nblk, bid); __syncthreads();
        pg8::gemm_phase<EpiBf16S, Proj1Order, true, true>(lds, g, S, (EpiBf16S{(bf16_t*)(ws + WS_QK), (bf16_t*)(ws + WS_V1), (bf16_t*)(ws + WS_G1), (bf16_t*)(ws + WS_A1), 2048, 256, 2048, 0})); }
    SYNC(12);
    if (RUN(13)) phase_glaprep(p, lds, tid, bid, nblk);
    SYNC(13);
    if (RUN(14)) phase_glascan(p, lds, tid, bid, nblk);
    SYNC(14);
    if (RUN(15)) phase_glafin(p, gw, nw, lane);
    SYNC(15);
    GEMM_RES(16, MIX, (const bf16_t*)(ws + WS_WGOUT), ML, 2048, 2048, (EpiResid{XL, XC, XL, XC, mod + 9 * 12288 + 4096}));
    if (RUN(17)) phase_norm(XL, XC, p.in[7] + 2048, mod + 9 * 12288, 6144, 8192, H, ML, gw, nw, lane);
    SYNC(17);
    GEMM_BF16(18, H, (const bf16_t*)(ws + WS_W1) + (size_t)8192 * 2048, ML, 8192, 2048, (EpiBf16S{(bf16_t*)(ws + WS_HID), nullptr, nullptr, nullptr, 8192, 0, 1 << 30, 1}));
    GEMM_RES(19, (const bf16_t*)(ws + WS_HID), (const bf16_t*)(ws + WS_W2) + (size_t)2048 * 8192, ML, 2048, 8192, (EpiResid{XL, XC, XL, XC, mod + 9 * 12288 + 10240}));
    if (RUN(20)) phase_final_norm(XL, p.in[10], gw, nw, lane);
}

extern "C" void kernel_launch(void* const* d_in, const int* in_sizes, int n_in, void* d_out, int out_size, void* d_ws, size_t ws_size, hipStream_t stream) {
    static int grid = 0;
    if (grid == 0) {
        if (n_in != 29 || ws_size < WS_END) { fprintf(stderr, "kernel_launch: need 29 inputs and %zu bytes of workspace; got %d, %zu\n", (size_t)WS_END, n_in, ws_size); grid = -1; return; }
        int dev = 0, cus = 0, per_cu = 0;
        hipGetDevice(&dev); hipDeviceGetAttribute(&cus, hipDeviceAttributeMultiprocessorCount, dev);
        if (hipFuncSetAttribute((const void*)fwd_mega, hipFuncAttributeMaxDynamicSharedMemorySize, LDS_BYTES) != hipSuccess) { fprintf(stderr, "kernel_launch: hipFuncSetAttribute failed\n"); grid = -1; return; }
        hipOccupancyMaxActiveBlocksPerMultiprocessor(&per_cu, (const void*)fwd_mega, 512, LDS_BYTES);
        if (per_cu < 1) per_cu = 1;
        (void)hipGetLastError();
        grid = cus * per_cu;
        if (grid > 256) grid = 256;
    }
    if (grid < 0) return;
    (void)hipMemsetAsync(d_ws, 0, 32768, stream);
    Params p{};
    for (int i = 0; i < 29; ++i) p.in[i] = (const float*)d_in[i];
    p.out = (float*)d_out; p.ws = (unsigned char*)d_ws;
#ifndef MK_MULTI
    p.ph_lo = 0; p.ph_hi = NPH;
    void* args[] = {&p};
    hipError_t e = hipLaunchCooperativeKernel((const void*)fwd_mega, dim3(grid), dim3(512), args, LDS_BYTES, stream);
    if (e != hipSuccess) fprintf(stderr, "cooperative launch failed: %s (grid %d)\n", hipGetErrorString(e), grid);
#else
    for (int ph = 0; ph < NPH; ++ph) { p.ph_lo = ph; p.ph_hi = ph + 1; hipLaunchKernelGGL(fwd_mega, dim3(grid), dim3(512), LDS_BYTES, stream, p); }
#endif
}
```

```cpp
#include <hip/hip_runtime.h>
#include <hip/hip_cooperative_groups.h>
#include <cstdio>
#include <cstdint>
namespace cg = cooperative_groups;
namespace pg8 {
#define PG8_LAS __attribute__((address_space(3)))
typedef unsigned short bf16_t;
typedef short bf16x8 __attribute__((ext_vector_type(8)));
typedef float f32x4 __attribute__((ext_vector_type(4)));
typedef unsigned u32x4 __attribute__((ext_vector_type(4)));
constexpr int BM = 256, BK = 64, HALF = 128, HTB = HALF * BK * 2  , STAGE_BYTES = 8 * HTB, NXCD = 8, WGM = 8;

__host__ __device__ __forceinline__ int lds_byte(int r, int c) { const int st = (r >> 4) * 2 + (c >> 5), rr = r & 15, cc = c & 31, ob = rr * 64 + cc * 2; return st * 1024 + (ob ^ (((ob >> 9) & 1) << 5)); }
__host__ __device__ __forceinline__ void stage_rc(int b, int& R, int& C) { const int st = b / 1024, sb = b % 1024, swz = sb ^ (((sb >> 9) & 1) << 5); R = (st >> 1) * 16 + swz / 64; C = (st & 1) * 32 + (swz % 64) / 2; }
__host__ __device__ __forceinline__ int perm32(int rho) { const int n = rho >> 4, i = rho & 15; return 8 * (i >> 2) + 4 * n + (i & 3); }

struct Unit { int pm, pn, ks; };
struct Gemm { const bf16_t* A; const bf16_t* Bt; int M, N, K, KL; };

struct StaticOrder {
    int nM, nN, nwg, G, c;
    __host__ __device__ void init(int M, int N, int G_, int c_) { nM = M / BM; nN = N / BM; nwg = nM * nN; G = G_; c = c_; }
    __host__ __device__ bool next(int i, Unit& u) const {
        const long L = (long)i * G + c; if (L >= nwg) return false;
        int wgid = (int)L; { const int q = nwg / NXCD, r = nwg % NXCD, xcd = wgid % NXCD, off = wgid / NXCD; wgid = (xcd < r ? xcd * (q + 1) : r * (q + 1) + (xcd - r) * q) + off; }
        const int nig = WGM * nN, gid = wgid / nig, fm = gid * WGM, gsz = (nM - fm) < WGM ? (nM - fm) : WGM;
        u.pm = fm + ((wgid % nig) % gsz); u.pn = (wgid % nig) / gsz; u.ks = 0; return true;
    }
    __device__ __forceinline__ void a_ready(const Unit&) const {}
    __device__ __forceinline__ void done(const Unit&) const {}
};
typedef __bf16 bf16v2_t0 __attribute__((ext_vector_type(2))); typedef float f32x2_t0 __attribute__((ext_vector_type(2)));
__device__ __forceinline__ unsigned cvt_pk_bf16(float lo, float hi) { const f32x2_t0 f = {lo, hi}; const bf16v2_t0 v = __builtin_convertvector(f, bf16v2_t0); return __builtin_bit_cast(unsigned, v); }
template <class Epi, class Sched, bool ALIGN_EPI = false, bool SP2 = false>
__device__ __forceinline__ void gemm_phase(PG8_LAS unsigned char* lds, const Gemm g, const Sched& S, const Epi& E) {
    const int tid = threadIdx.x, wid = __builtin_amdgcn_readfirstlane(tid >> 6), lane = tid & 63, wr = wid >> 2, wc = wid & 3, fr = lane & 15, fq = lane >> 4;
    const int K = g.K, nt = (g.KL ? g.KL : g.K) / BK; const size_t kspan = (size_t)g.KL * 2;
    unsigned voffA[2], voffB[2];
#pragma unroll
    for (int i = 0; i < 2; ++i) { int R, C; stage_rc(tid * 16 + i * 8192, R, C); const int Rb = Epi::PERM ? ((R & ~31) + perm32(R & 31)) : R;
        voffA[i] = (unsigned)(R * K + C) * 2u; voffB[i] = (unsigned)(Rb * K + C) * 2u; }
    const size_t kstep = (size_t)(BK * 2);
    const size_t hstep = (size_t)HALF * K * 2;
    const size_t tstep = 2 * hstep;
    const unsigned ldsw = (unsigned)wid * 1024u;
    const int aoff = lds_byte(wr * 64 + fr, fq * 8), boff = lds_byte(wc * 32 + fr, fq * 8);
#define PG8_SA(b, h) (((b) * 2 + (h)) * HTB)
#define PG8_SB(b, h) ((4 + (b) * 2 + (h)) * HTB)
#define PG8_STAGE(bufoff, gbase, voff) do { _Pragma("unroll") for (int _i = 0; _i < 2; ++_i) \
        __builtin_amdgcn_global_load_lds((const unsigned*)((const char*)(gbase) + (voff)[_i]), (PG8_LAS unsigned*)(lds + (bufoff) + ldsw + _i * 8192), 16, 0, 0); } while (0)
#define PG8_LDA(dst, b, h) do { _Pragma("unroll") for (int m = 0; m < 4; ++m) _Pragma("unroll") for (int k = 0; k < 2; ++k) dst[m][k] = *(const PG8_LAS bf16x8*)(lds + PG8_SA(b, h) + aoff + m * 2048 + k * 1024); } while (0)
#define PG8_LDB(dst, b, h) do { _Pragma("unroll") for (int n = 0; n < 2; ++n) _Pragma("unroll") for (int k = 0; k < 2; ++k) dst[n][k] = *(const PG8_LAS bf16x8*)(lds + PG8_SB(b, h) + boff + n * 2048 + k * 1024); } while (0)
#define PG8_MMA(ai, bj, At, Bt) do { __builtin_amdgcn_s_setprio(1); _Pragma("unroll") for (int m = 0; m < 4; ++m) _Pragma("unroll") for (int n = 0; n < 2; ++n) _Pragma("unroll") for (int k = 0; k < 2; ++k) \
        acc[ai][bj][m][n] = __builtin_amdgcn_mfma_f32_16x16x32_bf16(Bt[n][k], At[m][k], acc[ai][bj][m][n], 0, 0, 0); __builtin_amdgcn_s_setprio(0); } while (0)
#define PG8_WAIT_V(n) asm volatile("s_waitcnt vmcnt(" #n ")" ::: "memory")
#define PG8_WAIT_L(n) asm volatile("s_waitcnt lgkmcnt(" #n ")" ::: "memory")
#define PG8_BAR __builtin_amdgcn_s_barrier()
#define PG8_SCHED __builtin_amdgcn_sched_barrier(0)
    Unit cur, nxt; int ui = 0;
    if (!S.next(0, cur)) return;
    f32x4 acc[2][2][4][2];
#pragma unroll
    for (int a = 0; a < 2; ++a)
#pragma unroll
        for (int b = 0; b < 2; ++b)
#pragma unroll
            for (int m = 0; m < 4; ++m)
#pragma unroll
                for (int n = 0; n < 2; ++n) acc[a][b][m][n] = (f32x4){0.f, 0.f, 0.f, 0.f};
    bf16x8 At[4][2], B0[2][2], B1[2][2];
    const char* cA = (const char*)g.A + (size_t)cur.pm * tstep + (size_t)cur.ks * kspan; const char* cB = (const char*)g.Bt + (size_t)cur.pn * tstep + (size_t)cur.ks * kspan;
    S.a_ready(cur);
    if constexpr (SP2) {
        PG8_STAGE(PG8_SB(0, 0), cB, voffB); PG8_STAGE(PG8_SB(0, 1), cB + hstep, voffB); PG8_STAGE(PG8_SA(0, 0), cA, voffA); PG8_STAGE(PG8_SA(0, 1), cA + hstep, voffA);
        if (wr == 1) PG8_BAR;
        PG8_WAIT_V(2); PG8_BAR;
        PG8_STAGE(PG8_SB(1, 0), cB + kstep, voffB); PG8_STAGE(PG8_SA(1, 0), cA + kstep, voffA); PG8_STAGE(PG8_SB(1, 1), cB + hstep + kstep, voffB);
        PG8_WAIT_V(6); PG8_BAR;
    } else {
        PG8_STAGE(PG8_SB(0, 0), cB, voffB); PG8_STAGE(PG8_SA(0, 0), cA, voffA); PG8_STAGE(PG8_SB(0, 1), cB + hstep, voffB); PG8_STAGE(PG8_SA(0, 1), cA + hstep, voffA);
        if (wr == 1) PG8_BAR;
        PG8_WAIT_V(4); PG8_BAR;
        PG8_STAGE(PG8_SB(1, 0), cB + kstep, voffB); PG8_STAGE(PG8_SA(1, 0), cA + kstep, voffA); PG8_STAGE(PG8_SB(1, 1), cB + hstep + kstep, voffB);
        PG8_WAIT_V(6); PG8_BAR;
    }
    for (;;) {
        const bool has_next = S.next(ui + 1, nxt);
        const char* nA = has_next ? (const char*)g.A + (size_t)nxt.pm * tstep + (size_t)nxt.ks * kspan : cA; const char* nB = has_next ? (const char*)g.Bt + (size_t)nxt.pn * tstep + (size_t)nxt.ks * kspan : cB;
        for (int t = 0; t < nt; t += 2) {
            const bool last = (t == nt - 2);
            const char* a1 = cA + (size_t)(t + 1) * kstep;
            const char* a2 = last ? nA : cA + (size_t)(t + 2) * kstep; const char* b2 = last ? nB : cB + (size_t)(t + 2) * kstep;
            const char* a3 = a2 + kstep; const char* b3 = b2 + kstep;
            if (last && has_next) S.a_ready(nxt);
            if constexpr (SP2) {
            PG8_LDB(B0, 0, 0); PG8_LDB(B1, 0, 1); PG8_SCHED; PG8_LDA(At, 0, 0); PG8_STAGE(PG8_SA(1, 1), a1 + hstep, voffA);
            PG8_WAIT_V(8); PG8_WAIT_L(0); PG8_BAR; PG8_MMA(0, 0, At, B0); PG8_MMA(0, 1, At, B1); PG8_BAR; PG8_SCHED;
            PG8_LDA(At, 0, 1); PG8_STAGE(PG8_SB(0, 0), b2, voffB); PG8_STAGE(PG8_SB(0, 1), b2 + hstep, voffB); PG8_STAGE(PG8_SA(0, 0), a2, voffA);
            PG8_WAIT_V(8); PG8_WAIT_L(0); PG8_BAR; PG8_MMA(1, 0, At, B0); PG8_MMA(1, 1, At, B1); PG8_BAR; PG8_SCHED;
            PG8_LDB(B0, 1, 0); PG8_LDB(B1, 1, 1); PG8_SCHED; PG8_LDA(At, 1, 0); PG8_STAGE(PG8_SA(0, 1), a2 + hstep, voffA);
            PG8_WAIT_V(8); PG8_WAIT_L(0); PG8_BAR; PG8_MMA(0, 0, At, B0); PG8_MMA(0, 1, At, B1); PG8_BAR; PG8_SCHED;
            PG8_LDA(At, 1, 1); PG8_STAGE(PG8_SB(1, 0), b3, voffB); PG8_STAGE(PG8_SB(1, 1), b3 + hstep, voffB); PG8_STAGE(PG8_SA(1, 0), a3, voffA);
            PG8_WAIT_V(8); PG8_WAIT_L(0); PG8_BAR; PG8_MMA(1, 0, At, B0); PG8_MMA(1, 1, At, B1); PG8_BAR; PG8_SCHED;
            } else {
            PG8_LDB(B0, 0, 0); PG8_SCHED; PG8_LDA(At, 0, 0); PG8_STAGE(PG8_SA(1, 1), a1 + hstep, voffA);
            PG8_WAIT_L(8); PG8_BAR; PG8_WAIT_L(0); PG8_MMA(0, 0, At, B0); PG8_BAR; PG8_SCHED;
            PG8_LDB(B1, 0, 1); PG8_STAGE(PG8_SB(0, 0), b2, voffB);
            PG8_BAR; PG8_WAIT_L(0); PG8_MMA(0, 1, At, B1); PG8_BAR;
            PG8_LDA(At, 0, 1); PG8_STAGE(PG8_SA(0, 0), a2, voffA);
            PG8_BAR; PG8_WAIT_L(0); PG8_MMA(1, 0, At, B0); PG8_BAR; PG8_SCHED;
            PG8_STAGE(PG8_SB(0, 1), b2 + hstep, voffB);
            PG8_WAIT_V(6); PG8_BAR; PG8_MMA(1, 1, At, B1); PG8_BAR;
            PG8_LDB(B0, 1, 0); PG8_SCHED; PG8_LDA(At, 1, 0); PG8_STAGE(PG8_SA(0, 1), a2 + hstep, voffA);
            PG8_WAIT_L(8); PG8_BAR; PG8_WAIT_L(0); PG8_MMA(0, 0, At, B0); PG8_BAR; PG8_SCHED;
            PG8_LDB(B1, 1, 1); PG8_STAGE(PG8_SB(1, 0), b3, voffB);
            PG8_BAR; PG8_WAIT_L(0); PG8_MMA(0, 1, At, B1); PG8_BAR;
            PG8_LDA(At, 1, 1); PG8_STAGE(PG8_SA(1, 0), a3, voffA);
            PG8_BAR; PG8_WAIT_L(0); PG8_MMA(1, 0, At, B0); PG8_BAR; PG8_SCHED;
            PG8_STAGE(PG8_SB(1, 1), b3 + hstep, voffB);
            PG8_WAIT_V(6); PG8_BAR; PG8_MMA(1, 1, At, B1); PG8_BAR;
            }
        }
        if constexpr (ALIGN_EPI) { if (wr == 0) PG8_BAR; }
        if constexpr (!Epi::AFTER_DRAIN) { E(acc, cur, wr, wc, fr, fq); S.done(cur); }
        if (!has_next) break;
#pragma unroll
        for (int a = 0; a < 2; ++a)
#pragma unroll
            for (int b = 0; b < 2; ++b)
#pragma unroll
                for (int m = 0; m < 4; ++m)
#pragma unroll
                    for (int n = 0; n < 2; ++n) acc[a][b][m][n] = (f32x4){0.f, 0.f, 0.f, 0.f};
        cur = nxt; cA = nA; cB = nB; ++ui;
        if constexpr (ALIGN_EPI) { if (wr == 1) PG8_BAR; }
    }
    PG8_WAIT_V(0);
    if constexpr (!ALIGN_EPI) { if (wr == 0) PG8_BAR; }
    PG8_BAR;
    if constexpr (Epi::AFTER_DRAIN) { E.fused(acc, cur, wr, wc, fr, fq, lds, wid, lane); S.done(cur); }
#undef PG8_SA
#undef PG8_SB
#undef PG8_STAGE
#undef PG8_LDA
#undef PG8_LDB
#undef PG8_MMA
#undef PG8_WAIT_V
#undef PG8_WAIT_L
#undef PG8_BAR
#undef PG8_SCHED
}
}

#define LAS __attribute__((address_space(3)))
using pg8::bf16_t; using pg8::bf16x8; using pg8::f32x4; using pg8::u32x4;
typedef unsigned u32x2 __attribute__((ext_vector_type(2)));
typedef float f32x2 __attribute__((ext_vector_type(2)));
#define MFMA16(a, b, c) __builtin_amdgcn_mfma_f32_16x16x32_bf16((a), (b), (c), 0, 0, 0)

constexpr int ML = 16384, MC = 2048, MT = 18432, DM = 2048;
constexpr int LDS_BYTES = 155648;
constexpr int NPH = 21;
constexpr int P0LD = 4160;

constexpr size_t al256(size_t x) { return (x + 255) & ~(size_t)255; }
constexpr size_t WS_MOD   = 32768;
constexpr size_t WS_WABIN = al256(WS_MOD + (size_t)2 * 9 * 12288 * 4);
constexpr size_t WS_WABOUT = WS_WABIN + (size_t)4096 * 2048 * 2;
constexpr size_t WS_WGLU  = WS_WABOUT + (size_t)2048 * 2048 * 2;
constexpr size_t WS_W1    = WS_WGLU + (size_t)1024 * 1024 * 2;
constexpr size_t WS_W2    = WS_W1 + (size_t)2 * 8192 * 2048 * 2;
constexpr size_t WS_WGIN  = WS_W2 + (size_t)2 * 8192 * 2048 * 2;
constexpr size_t WS_WGOUT = WS_WGIN + (size_t)6400 * 2048 * 2;
constexpr size_t WS_XC    = WS_WGOUT + (size_t)2048 * 2048 * 2;
constexpr size_t WS_H     = WS_XC + (size_t)MC * DM * 4;
constexpr size_t WS_MIX   = WS_H + (size_t)MT * DM * 2;
constexpr size_t WS_BIG   = WS_MIX + (size_t)MT * DM * 2;
constexpr size_t WS_PROJ0 = WS_BIG;
constexpr size_t WS_VT0   = WS_PROJ0 + (size_t)MT * P0LD * 2;
constexpr size_t WS_YS5   = WS_VT0 + (size_t)8192 * 2304 * 2;
constexpr size_t WS_GL    = WS_YS5 + (size_t)2 * MT * 1024 * 2;
constexpr size_t WS_L0END = WS_GL + (size_t)MT * 1024 * 2;
constexpr size_t WS_HID   = WS_BIG;
constexpr size_t WS_HIDEND = WS_HID + (size_t)MT * 8192 * 2;
constexpr size_t WS_PART  = WS_HIDEND;
constexpr size_t WS_PARTEND = WS_PART + (size_t)4 * MC * DM * 4;
constexpr size_t WS_QK    = WS_BIG;
constexpr size_t WS_V1    = WS_QK + (size_t)MT * 2048 * 2;
constexpr size_t WS_G1    = WS_V1 + (size_t)MT * 2048 * 2;
constexpr size_t WS_A1    = WS_G1 + (size_t)MT * 2048 * 2;
constexpr size_t WS_QIN   = WS_A1 + (size_t)MT * 256 * 2;
constexpr size_t WS_KIN   = WS_QIN + (size_t)2 * MT * 1024 * 2;
constexpr size_t WS_DEC   = WS_KIN + (size_t)2 * MT * 1024 * 2;
constexpr size_t WS_L1END = WS_DEC + (size_t)2 * 288 * 4 * 256 * 4;
constexpr size_t WS_KENDT = WS_MIX;
constexpr size_t WS_VT1   = WS_H;
constexpr size_t cmax(size_t a, size_t b) { return a > b ? a : b; }
constexpr size_t WS_END   = cmax(cmax(WS_L0END, WS_PARTEND), WS_L1END);

struct Params { const float* in[29]; float* out; unsigned char* ws; int ph_lo, ph_hi; };

typedef __bf16 bf16v2_t __attribute__((ext_vector_type(2)));
__device__ __forceinline__ unsigned pk_bf16(float lo, float hi) { const f32x2 f = {lo, hi}; const bf16v2_t v = __builtin_convertvector(f, bf16v2_t); return __builtin_bit_cast(unsigned, v); }
__device__ __forceinline__ float bf_lo(unsigned u) { return __uint_as_float(u << 16); }
__device__ __forceinline__ float bf_hi(unsigned u) { return __uint_as_float(u & 0xffff0000u); }
__device__ __forceinline__ float bf1(bf16_t h) { return __uint_as_float((unsigned)h << 16); }
__device__ __forceinline__ float wave_sum(float v) {
#pragma unroll
    for (int o = 1; o < 64; o <<= 1) v += __shfl_xor(v, o);
    return v;
}
#define WAVE_LDS_SYNC() asm volatile("s_waitcnt lgkmcnt(0)" ::: "memory")

struct EpiBf16S {
    static constexpr bool PERM = true, AFTER_DRAIN = false;
    bf16_t *O0, *O1, *O2, *O3; int ld0, ld3; int split_cols; int act;
    __device__ __forceinline__ void operator()(const f32x4 (&acc)[2][2][4][2], const pg8::Unit& u, int wr, int wc, int fr, int fq) const {
        int colt = u.pn * 256; const int t = colt / split_cols; colt -= t * split_cols;
        bf16_t* base = t == 0 ? O0 : (t == 1 ? O1 : (t == 2 ? O2 : O3)); const int ld = t == 3 ? ld3 : ld0;
        const int row0 = u.pm * 256 + wr * 64 + fr, col0 = colt + wc * 32 + 8 * fq;
#pragma unroll
        for (int ai = 0; ai < 2; ++ai)
#pragma unroll
            for (int m = 0; m < 4; ++m) { bf16_t* rowp = base + (size_t)(row0 + ai * 128 + m * 16) * ld + col0;
#pragma unroll
                for (int bj = 0; bj < 2; ++bj) { f32x4 v0 = acc[ai][bj][m][0], v1 = acc[ai][bj][m][1];
                    if (act) {
#pragma unroll
                        for (int e = 0; e < 4; ++e) { float a = fmaxf(v0[e], 0.f), b = fmaxf(v1[e], 0.f); v0[e] = a * a; v1[e] = b * b; } }
                    u32x4 w; w.x = pk_bf16(v0[0], v0[1]); w.y = pk_bf16(v0[2], v0[3]); w.z = pk_bf16(v1[0], v1[1]); w.w = pk_bf16(v1[2], v1[3]);
                    *(u32x4*)(rowp + bj * 128) = w; } }
    }
};
struct EpiGlu {
    static constexpr bool PERM = true, AFTER_DRAIN = false;
    const bf16_t* GL; const float* bias; bf16_t* MIX;
    __device__ __forceinline__ void operator()(const f32x4 (&acc)[2][2][4][2], const pg8::Unit& u, int wr, int wc, int fr, int fq) const {
        const int row0 = u.pm * 256 + wr * 64 + fr, col0 = u.pn * 256 + wc * 32 + 8 * fq;
#pragma unroll
        for (int bj = 0; bj < 2; ++bj) { const int col = col0 + bj * 128;
            const f32x4 b0 = *(const f32x4*)(bias + col), b1 = *(const f32x4*)(bias + col + 4);
#pragma unroll
            for (int ai = 0; ai < 2; ++ai)
#pragma unroll
                for (int m = 0; m < 4; ++m) { const size_t row = (size_t)(row0 + ai * 128 + m * 16);
                    const u32x4 g = *(const u32x4*)(GL + row * 1024 + col);
                    const f32x4 v0 = acc[ai][bj][m][0] + b0, v1 = acc[ai][bj][m][1] + b1;
                    float gl[8] = {bf_lo(g.x), bf_hi(g.x), bf_lo(g.y), bf_hi(g.y), bf_lo(g.z), bf_hi(g.z), bf_lo(g.w), bf_hi(g.w)};
                    float o[8];
#pragma unroll
                    for (int e = 0; e < 4; ++e) { o[e] = gl[e] / (1.f + __expf(-v0[e])); o[4 + e] = gl[4 + e] / (1.f + __expf(-v1[e])); }
                    u32x4 w; w.x = pk_bf16(o[0], o[1]); w.y = pk_bf16(o[2], o[3]); w.z = pk_bf16(o[4], o[5]); w.w = pk_bf16(o[6], o[7]);
                    *(u32x4*)(MIX + row * 2048 + 1024 + col) = w; } }
    }
};
struct EpiResid {
    static constexpr bool PERM = true, AFTER_DRAIN = false;
    const float *inL, *inC; float *outL, *outC; const float* gate;
    __device__ __forceinline__ void operator()(const f32x4 (&acc)[2][2][4][2], const pg8::Unit& u, int wr, int wc, int fr, int fq) const {
        const int r0 = u.pm * 256; const bool lat = r0 < ML;
        const char* in = (const char*)(lat ? inL + (size_t)r0 * DM : inC + (size_t)(r0 - ML) * DM);
        char* out = (char*)(lat ? outL + (size_t)r0 * DM : outC + (size_t)(r0 - ML) * DM);
        const char* gp = (const char*)(gate + (size_t)(lat ? (r0 >> 11) : 8) * 12288);
        const unsigned colb = (unsigned)(u.pn * 256 + wc * 32 + 8 * fq) * 4u;
        const unsigned rowb = (unsigned)(wr * 64 + fr) * (unsigned)(DM * 4) + colb;
#pragma unroll
        for (int bj = 0; bj < 2; ++bj) {
            const f32x4 g0 = *(const f32x4*)(gp + colb + bj * 512), g1 = *(const f32x4*)(gp + colb + bj * 512 + 16);
#pragma unroll
            for (int ai = 0; ai < 2; ++ai)
#pragma unroll
                for (int m = 0; m < 4; ++m) { const unsigned off = rowb + (unsigned)((ai * 128 + m * 16) * DM * 4 + bj * 512);
                    const f32x4 x0 = *(const f32x4*)(in + off), x1 = *(const f32x4*)(in + off + 16);
                    *(f32x4*)(out + off) = x0 + g0 * acc[ai][bj][m][0];
                    *(f32x4*)(out + off + 16) = x1 + g1 * acc[ai][bj][m][1]; } }
    }
};

struct EpiPart {
    static constexpr bool PERM = true, AFTER_DRAIN = false;
    float* P;
    __device__ __forceinline__ void operator()(const f32x4 (&acc)[2][2][4][2], const pg8::Unit& u, int wr, int wc, int fr, int fq) const {
        char* out = (char*)(P + ((size_t)u.ks * MC + (size_t)(u.pm * 256 - ML)) * DM);
        const unsigned colb = (unsigned)(u.pn * 256 + wc * 32 + 8 * fq) * 4u;
        const unsigned rowb = (unsigned)(wr * 64 + fr) * (unsigned)(DM * 4) + colb;
#pragma unroll
        for (int bj = 0; bj < 2; ++bj)
#pragma unroll
            for (int ai = 0; ai < 2; ++ai)
#pragma unroll
                for (int m = 0; m < 4; ++m) { const unsigned off = rowb + (unsigned)((ai * 128 + m * 16) * DM * 4 + bj * 512);
                    *(f32x4*)(out + off) = acc[ai][bj][m][0]; *(f32x4*)(out + off + 16) = acc[ai][bj][m][1]; }
    }
};
struct SplitOrder {
    int G, c;
    __device__ bool next(int i, pg8::Unit& u) const { const long L = (long)i * G + c; if (L >= 256) return false; u.ks = (int)(L & 3); u.pn = (int)((L >> 2) & 7); u.pm = 64 + (int)(L >> 5); return true; }
    __device__ __forceinline__ void a_ready(const pg8::Unit&) const {}
    __device__ __forceinline__ void done(const pg8::Unit&) const {}
};

struct Proj1Order {
    pg8::StaticOrder S0; int G, c;
    __device__ void init(int G_, int c_) { S0.init(ML, 6400, G_, c_); G = G_; c = c_; }
    __device__ bool next(int i, pg8::Unit& u) const {
        const long L = (long)i * G + c;
        if (L < 1600) return S0.next(i, u);
        const int j = (int)(L - 1600); if (j >= 104) return false;
        const int jj = j % 13; u.pm = 64 + j / 13; u.pn = jj < 12 ? 4 + jj : 24; u.ks = 0; return true; }
    __device__ __forceinline__ void a_ready(const pg8::Unit&) const {}
    __device__ __forceinline__ void done(const pg8::Unit&) const {}
};

__device__ __forceinline__ void xpose_mat(const float* __restrict__ src, bf16_t* __restrict__ dst, int K, int N, int Npad, LAS unsigned* l32, int tid, int bid, int nblk) {
    const int nkt = K / 128, nnt = Npad / 64, tiles = nkt * nnt;
    const int n = tid & 63, kp0 = (tid >> 6) * 8;
    float cur[16], nxt[16];
    auto fetch = [&](int T, float (&v)[16]) { const int kt = T % nkt, ntile = T / nkt; const int k0 = kt * 128, n0 = ntile * 64; const bool ok = (n0 + n) < N;
        const float* sp = src + (size_t)(k0 + 2 * kp0) * N + n0 + n;
#pragma unroll
        for (int i = 0; i < 16; ++i) v[i] = ok ? sp[(size_t)i * N] : 0.f; };
    int T = bid;
    if (T < tiles) fetch(T, cur);
    for (; T < tiles; T += nblk) {
        const int kt = T % nkt, ntile = T / nkt; const int k0 = kt * 128, n0 = ntile * 64;
        const bool more = T + nblk < tiles;
        if (more) fetch(T + nblk, nxt);
#pragma unroll
        for (int i = 0; i < 8; ++i) l32[n * 65 + kp0 + i] = pk_bf16(cur[2 * i], cur[2 * i + 1]);
        __syncthreads();
#pragma unroll
        for (int q = 0; q < 2; ++q) {
            const int nn = q * 32 + (tid >> 4), j = tid & 15;
            u32x4 w; w.x = l32[nn * 65 + 4 * j]; w.y = l32[nn * 65 + 4 * j + 1]; w.z = l32[nn * 65 + 4 * j + 2]; w.w = l32[nn * 65 + 4 * j + 3];
            *(u32x4*)(dst + (size_t)(n0 + nn) * K + k0 + 8 * j) = w;
        }
        __syncthreads();
        if (more) {
#pragma unroll
            for (int i = 0; i < 16; ++i) cur[i] = nxt[i]; }
    }
}

__device__ __forceinline__ void phase_prep(const Params& p, LAS unsigned char* lds, int tid, int bid, int nblk) {
    const int wid = tid >> 6, lane = tid & 63;
    LAS float* sl = (LAS float*)lds;
    LAS float* red = sl + 9 * 2048;
    for (int i = tid; i < 9 * 2048; i += 512) { const float v = i < 8 * 2048 ? p.in[1][i] : p.in[3][i - 8 * 2048]; sl[i] = v / (1.f + expf(-v)); }
    __syncthreads();
    float* mod = (float*)(p.ws + WS_MOD);
    const int c4 = (lane & 15) * 4, ksub = lane >> 4;
    for (int item = bid; item < 384; item += nblk) {
        const int l = item / 192, cc = (item % 192) * 64;
        const float* W = p.in[4] + (size_t)l * 2048 * 12288 + cc + c4;
        f32x4 acc[9];
#pragma unroll
        for (int r = 0; r < 9; ++r) acc[r] = (f32x4){0.f, 0.f, 0.f, 0.f};
        const int k0 = wid * 256 + ksub;
        for (int kk = 0; kk < 256; kk += 32) {
            f32x4 w[8];
#pragma unroll
            for (int u = 0; u < 8; ++u) w[u] = *(const f32x4*)(W + (size_t)(k0 + kk + 4 * u) * 12288);
#pragma unroll
            for (int u = 0; u < 8; ++u)
#pragma unroll
                for (int r = 0; r < 9; ++r) acc[r] += w[u] * sl[r * 2048 + k0 + kk + 4 * u];
        }
#pragma unroll
        for (int r = 0; r < 9; ++r) {
#pragma unroll
            for (int e = 0; e < 4; ++e) { float v = acc[r][e]; v += __shfl_xor(v, 16); v += __shfl_xor(v, 32); acc[r][e] = v; }
            if (ksub == 0) *(LAS f32x4*)(red + (wid * 9 + r) * 64 + c4) = acc[r]; }
        __syncthreads();
        for (int o = tid; o < 576; o += 512) { const int r = o >> 6, c = o & 63; float s_ = 0.f;
#pragma unroll
            for (int w = 0; w < 8; ++w) s_ += red[(w * 9 + r) * 64 + c];
            mod[(size_t)(l * 9 + r) * 12288 + cc + c] = s_ + p.in[5][l * 12288 + cc + c]; }
        __syncthreads();
    }
    LAS unsigned* l32 = (LAS unsigned*)lds;
    __syncthreads();
    if ((nblk & 1) == 0 && nblk >= 2) { if (bid >= nblk / 2) xpose_mat(p.in[11], (bf16_t*)(p.ws + WS_WABIN), 2048, 4096, 4096, l32, tid, bid - nblk / 2, nblk / 2); }
    else xpose_mat(p.in[11], (bf16_t*)(p.ws + WS_WABIN), 2048, 4096, 4096, l32, tid, bid, nblk);
}

__device__ __forceinline__ void phase_norm(const float* XL, const float* XC, const float* gvec, const float* modl, int sh_off, int sc_off, bf16_t* H, int nrows, int gw, int nw, int lane, const float* PART = nullptr, const float* pgate = nullptr) {
    for (int row = gw; row < nrows; row += nw) {
        const float* x = row < ML ? XL + (size_t)row * DM : XC + (size_t)(row - ML) * DM;
        const float* mr = modl + (size_t)(row < ML ? (row >> 11) : 8) * 12288;
        f32x4 v[8]; float ss = 0.f;
#pragma unroll
        for (int i = 0; i < 8; ++i) { v[i] = *(const f32x4*)(x + i * 256 + lane * 4);
            if (PART && row >= ML) { const float* pp = PART + (size_t)(row - ML) * DM + i * 256 + lane * 4;
                const f32x4 ps = (*(const f32x4*)pp + *(const f32x4*)(pp + (size_t)MC * DM)) + (*(const f32x4*)(pp + (size_t)2 * MC * DM) + *(const f32x4*)(pp + (size_t)3 * MC * DM));
                v[i] = v[i] + *(const f32x4*)(pgate + i * 256 + lane * 4) * ps; }
            ss += v[i][0] * v[i][0] + v[i][1] * v[i][1] + v[i][2] * v[i][2] + v[i][3] * v[i][3]; }
        ss = wave_sum(ss);
        const float rstd = rsqrtf(ss * (1.f / 2048.f) + 1e-6f);
#pragma unroll
        for (int i = 0; i < 8; ++i) { const int col = i * 256 + lane * 4;
            const f32x4 g = *(const f32x4*)(gvec + col), sc = *(const f32x4*)(mr + sc_off + col), sh = *(const f32x4*)(mr + sh_off + col);
            const f32x4 y = v[i] * rstd * g * (sc + 1.f) + sh;
            u32x2 w; w.x = pk_bf16(y[0], y[1]); w.y = pk_bf16(y[2], y[3]);
            *(u32x2*)(H + (size_t)row * DM + col) = w; }
    }
}
__device__ __forceinline__ void phase_final_norm(float* X, const float* gvec, int gw, int nw, int lane) {
    for (int row = gw; row < ML; row += nw) {
        float* x = X + (size_t)row * DM;
        f32x4 v[8]; float ss = 0.f;
#pragma unroll
        for (int i = 0; i < 8; ++i) { v[i] = *(const f32x4*)(x + i * 256 + lane * 4); ss += v[i][0] * v[i][0] + v[i][1] * v[i][1] + v[i][2] * v[i][2] + v[i][3] * v[i][3]; }
        ss = wave_sum(ss);
        const float rstd = rsqrtf(ss * (1.f / 2048.f) + 1e-6f);
#pragma unroll
        for (int i = 0; i < 8; ++i) { const int col = i * 256 + lane * 4; const f32x4 g = *(const f32x4*)(gvec + col); *(f32x4*)(x + col) = v[i] * rstd * g; }
    }
}

__device__ __forceinline__ void phase_vt0(const Params& p, int tid, int bid, int nblk) {
    const bf16_t* P0 = (const bf16_t*)(p.ws + WS_PROJ0); bf16_t* VT = (bf16_t*)(p.ws + WS_VT0);
    for (int item = bid; item < 576; item += nblk) {
        const int cid = item >> 1, vc = (item & 1) * 512 + tid;
        int b, pos0;
        if (cid < 256) { b = cid >> 5; pos0 = 256 + (cid & 31) * 64; } else { const int cc = cid - 256; b = cc >> 2; pos0 = (cc & 3) * 64; }
        const bf16_t* src = P0 + (size_t)cid * 64 * P0LD + 2048 + vc;
        bf16_t* dst = VT + (((size_t)(b * 8 + (vc >> 7)) * 288 + (pos0 >> 3)) * 128 + (vc & 127)) * 8;
#pragma unroll
        for (int q = 0; q < 8; ++q) { unsigned w[4];
#pragma unroll
            for (int e = 0; e < 4; ++e) { const unsigned lo = src[(size_t)(q * 8 + 2 * e) * P0LD], hi = src[(size_t)(q * 8 + 2 * e + 1) * P0LD]; w[e] = lo | (hi << 16); }
            u32x4 o; o.x = w[0]; o.y = w[1]; o.z = w[2]; o.w = w[3];
            *(u32x4*)(dst + (size_t)q * 1024) = o; }
    }
}

__device__ __forceinline__ void s5_disc(float lr, float li, float dt, float& ar, float& ai, float& f_r, float& f_i) {
    const float mag = expf(lr * dt); float sn, cs; sincosf(li * dt, &sn, &cs);
    ar = mag * cs; ai = mag * sn; const float den = lr * lr + li * li;
    f_r = ((ar - 1.f) * lr + ai * li) / den; f_i = (ai * lr - (ar - 1.f) * li) / den;
}
__device__ __forceinline__ void s5_wave(const Params& p, int sw, LAS unsigned char* wl, int lane) {
    const int b = sw >> 7, g = (sw >> 1) & 63, dir = sw & 1;
    const int fr = lane & 15, fq = lane >> 4;
    const int pg = dir * 64 + g;
    const float* LR = p.in[14] + pg * 64; const float* LI = p.in[15] + pg * 64;
    const float dt = expf(p.in[16][pg]);
    const float* BR = p.in[17] + (size_t)pg * 1024; const float* BI = p.in[18] + (size_t)pg * 1024;
    const float* CR = p.in[19] + (size_t)pg * 1024; const float* CI = p.in[20] + (size_t)pg * 1024;
    float ar, ai; { float t0, t1; s5_disc(LR[lane], LI[lane], dt, ar, ai, t0, t1); }
    bf16x8 bbA[8];
#pragma unroll
    for (int q = 0; q < 8; ++q) {
        const int sg = q * 16 + fr, pp = sg >> 1, part = sg & 1;
        float a_r, a_i, f_r, f_i; s5_disc(LR[pp], LI[pp], dt, a_r, a_i, f_r, f_i);
        u32x4 w = {0u, 0u, 0u, 0u};
        if (fq < 2) {
            const f32x4 br0 = *(const f32x4*)(BR + pp * 16 + fq * 8), br1 = *(const f32x4*)(BR + pp * 16 + fq * 8 + 4);
            const f32x4 bi0 = *(const f32x4*)(BI + pp * 16 + fq * 8), bi1 = *(const f32x4*)(BI + pp * 16 + fq * 8 + 4);
            f32x4 v0, v1;
            if (part == 0) { v0 = br0 * f_r - bi0 * f_i; v1 = br1 * f_r - bi1 * f_i; } else { v0 = bi0 * f_r + br0 * f_i; v1 = bi1 * f_r + br1 * f_i; }
            w.x = pk_bf16(v0[0], v0[1]); w.y = pk_bf16(v0[2], v0[3]); w.z = pk_bf16(v1[0], v1[1]); w.w = pk_bf16(v1[2], v1[3]);
        }
        bbA[q] = __builtin_bit_cast(bf16x8, w);
    }
    bf16x8 cA[4];
#pragma unroll
    for (int kk = 0; kk < 4; ++kk) { const int p0 = kk * 16 + fq * 4;
        const f32x4 cr = *(const f32x4*)(CR + fr * 64 + p0), ci = *(const f32x4*)(CI + fr * 64 + p0);
        u32x4 w; w.x = pk_bf16(cr[0], -ci[0]); w.y = pk_bf16(cr[1], -ci[1]); w.z = pk_bf16(cr[2], -ci[2]); w.w = pk_bf16(cr[3], -ci[3]);
        cA[kk] = __builtin_bit_cast(bf16x8, w); }
    LAS float* BU = (LAS float*)wl;
    LAS unsigned* HH = (LAS unsigned*)(wl + 16 * 132 * 4);
    const bf16_t* P0 = (const bf16_t*)(p.ws + WS_PROJ0);
    bf16_t* YS = (bf16_t*)(p.ws + WS_YS5) + (size_t)dir * MT * 1024;
    float hr = 0.f, hi = 0.f;
    const f32x4 z4 = {0.f, 0.f, 0.f, 0.f};
    auto rowof = [&](int ti_) { const int s = ti_ * 16 + fr;
        return dir == 0 ? (s < 256 ? ML + b * 256 + s : b * 2048 + (s - 256)) : (s < 256 ? ML + b * 256 + 255 - s : b * 2048 + 2047 - (s - 256)); };
    int row_n = rowof(0);
    u32x4 uw_n = {0u, 0u, 0u, 0u};
    if (fq < 2) uw_n = *(const u32x4*)(P0 + (size_t)row_n * P0LD + 3072 + g * 16 + fq * 8);
    for (int ti = 0; ti < 144; ++ti) {
        const int row = row_n; const bf16x8 ub = __builtin_bit_cast(bf16x8, uw_n);
        if (ti + 1 < 144) { row_n = rowof(ti + 1); if (fq < 2) uw_n = *(const u32x4*)(P0 + (size_t)row_n * P0LD + 3072 + g * 16 + fq * 8); }
#pragma unroll
        for (int q = 0; q < 8; ++q) { const f32x4 d = MFMA16(bbA[q], ub, z4); *(LAS f32x4*)(BU + fr * 132 + q * 16 + fq * 4) = d; }
        WAVE_LDS_SYNC();
        f32x2 bu[16];
#pragma unroll
        for (int t = 0; t < 16; ++t) bu[t] = *(const LAS f32x2*)(BU + t * 132 + 2 * lane);
#pragma unroll
        for (int t = 0; t < 16; ++t) {
            const float nr = ar * hr - ai * hi + bu[t].x, ni = ar * hi + ai * hr + bu[t].y; hr = nr; hi = ni;
            HH[t * 68 + lane] = pk_bf16(hr, hi); }
        WAVE_LDS_SYNC();
        f32x4 y = z4;
#pragma unroll
        for (int kk = 0; kk < 4; ++kk) { const bf16x8 hb = *(const LAS bf16x8*)(HH + fr * 68 + kk * 16 + fq * 4); y = MFMA16(cA[kk], hb, y); }
        u32x2 o; o.x = pk_bf16(y[0], y[1]); o.y = pk_bf16(y[2], y[3]);
        *(u32x2*)(YS + (size_t)row * 1024 + g * 16 + fq * 4) = o;
        WAVE_LDS_SYNC();
    }
}

__device__ __forceinline__ void na_item(const Params& p, int item, int lane, const LAS float* RBL) {
    const bf16_t* P0 = (const bf16_t*)(p.ws + WS_PROJ0); const bf16_t* VT = (const bf16_t*)(p.ws + WS_VT0); bf16_t* MIX = (bf16_t*)(p.ws + WS_MIX);
    const int fr = lane & 15, fq = lane >> 4;
    int b, h, c0 = 0, ks0 = 0, nwin = 0, rsA = 0, rsB = 0, rA = 0, rB = 0, qrowA, qrowB;
    if (item < 4096) { b = item >> 9; const int rem = item & 511; h = rem >> 6; const int pr = rem & 63; rA = (pr >> 2) * 2; rB = rA + 1; c0 = (pr & 3) * 16;
        rsA = min(max(rA - 4, 0), 24); rsB = min(max(rB - 4, 0), 24); nwin = rsB - rsA + 8; ks0 = min(max(c0 - 8, 0), 32);
        qrowA = b * 2048 + rA * 64 + c0 + fr; qrowB = qrowA + 64; }
    else { const int it = item - 4096; b = it >> 6; h = (it >> 3) & 7; qrowA = ML + b * 256 + (it & 7) * 32 + fr; qrowB = qrowA + 16; }
    const int nblkk = 8 + nwin;
    bf16x8 qfA[4], qfB[4];
#pragma unroll
    for (int kk = 0; kk < 4; ++kk) { qfA[kk] = *(const bf16x8*)(P0 + (size_t)qrowA * P0LD + h * 128 + kk * 32 + fq * 8); qfB[kk] = *(const bf16x8*)(P0 + (size_t)qrowB * P0LD + h * 128 + kk * 32 + fq * 8); }
    float mA = -1e30f, lA = 0.f, mB = -1e30f, lB = 0.f;
    f32x4 oA[8], oB[8];
    const f32x4 z4 = {0.f, 0.f, 0.f, 0.f};
#pragma unroll
    for (int dt = 0; dt < 8; ++dt) { oA[dt] = z4; oB[dt] = z4; }
    const int qcol = c0 + fr, wst = min(max(qcol - 8, 0), 48);
    auto krow_of = [&](int blk_) { return blk_ < 8 ? ML + b * 256 + blk_ * 32 : b * 2048 + (rsA + blk_ - 8) * 64 + ks0; };
    const int kperm = (fr >> 2) * 8 + (fr & 3);
    bf16x8 kc0[4], kc1[4];
    { const bf16_t* kp0 = P0 + (size_t)(krow_of(0) + kperm) * P0LD + 1024 + h * 128 + fq * 8;
#pragma unroll
      for (int kk = 0; kk < 4; ++kk) { kc0[kk] = *(const bf16x8*)(kp0 + kk * 32); kc1[kk] = *(const bf16x8*)(kp0 + (size_t)4 * P0LD + kk * 32); } }
    for (int blk = 0; blk < nblkk; ++blk) {
        const int wrow = rsA + blk - 8;
        const int vpos0 = blk < 8 ? blk * 32 : 256 + wrow * 64 + ks0;
        const bf16_t* vp = VT + (((size_t)(b * 8 + h) * 288 + (vpos0 >> 3) + fq) * 128 + fr) * 8;
        u32x4 vv[8];
#pragma unroll
        for (int dt = 0; dt < 8; ++dt) vv[dt] = *(const u32x4*)(vp + dt * 128);
        bf16x8 kn0[4], kn1[4];
        { const int nb = blk + 1 < nblkk ? blk + 1 : blk; const bf16_t* kp0 = P0 + (size_t)(krow_of(nb) + kperm) * P0LD + 1024 + h * 128 + fq * 8;
#pragma unroll
          for (int kk = 0; kk < 4; ++kk) { kn0[kk] = *(const bf16x8*)(kp0 + kk * 32); kn1[kk] = *(const bf16x8*)(kp0 + (size_t)4 * P0LD + kk * 32); } }
        f32x4 a0 = z4, a1 = z4, b0 = z4, b1 = z4;
#pragma unroll
        for (int kk = 0; kk < 4; ++kk) { a0 = MFMA16(kc0[kk], qfA[kk], a0); a1 = MFMA16(kc1[kk], qfA[kk], a1); b0 = MFMA16(kc0[kk], qfB[kk], b0); b1 = MFMA16(kc1[kk], qfB[kk], b1); }
        float sA[8], sB[8];
#pragma unroll
        for (int jj = 0; jj < 4; ++jj) { sA[jj] = a0[jj] * 0.08838834764831845f; sA[4 + jj] = a1[jj] * 0.08838834764831845f; sB[jj] = b0[jj] * 0.08838834764831845f; sB[4 + jj] = b1[jj] * 0.08838834764831845f; }
        if (blk >= 8) {
            const bool actA = wrow >= rsA && wrow < rsA + 8, actB = wrow >= rsB && wrow < rsB + 8;
            const int riA = min(max(wrow - rA + 7, 0), 14), riB = min(max(wrow - rB + 7, 0), 14);
            const LAS float* rbA = RBL + (h * 15 + riA) * 31; const LAS float* rbB = RBL + (h * 15 + riB) * 31;
            float bvA[8], bvB[8];
#pragma unroll
            for (int e = 0; e < 8; ++e) { const int ci = min(max(ks0 + fq * 8 + e - qcol + 15, 0), 30); bvA[e] = rbA[ci]; bvB[e] = rbB[ci]; }
#pragma unroll
            for (int e = 0; e < 8; ++e) { const int kcol = ks0 + fq * 8 + e; const bool ok = kcol >= wst && kcol < wst + 16;
                sA[e] = (ok && actA) ? sA[e] + bvA[e] : -1e30f; sB[e] = (ok && actB) ? sB[e] + bvB[e] : -1e30f; } }
        float bmA = sA[0], bmB = sB[0];
#pragma unroll
        for (int e = 1; e < 8; ++e) { bmA = fmaxf(bmA, sA[e]); bmB = fmaxf(bmB, sB[e]); }
        bmA = fmaxf(bmA, __shfl_xor(bmA, 16)); bmA = fmaxf(bmA, __shfl_xor(bmA, 32)); bmB = fmaxf(bmB, __shfl_xor(bmB, 16)); bmB = fmaxf(bmB, __shfl_xor(bmB, 32));
        const float mnA = fmaxf(mA, bmA), alA = __expf(mA - mnA), mnB = fmaxf(mB, bmB), alB = __expf(mB - mnB);
        float psA = 0.f, psB = 0.f;
#pragma unroll
        for (int e = 0; e < 8; ++e) { sA[e] = __expf(sA[e] - mnA); psA += sA[e]; sB[e] = __expf(sB[e] - mnB); psB += sB[e]; }
        psA += __shfl_xor(psA, 16); psA += __shfl_xor(psA, 32); psB += __shfl_xor(psB, 16); psB += __shfl_xor(psB, 32);
        lA = lA * alA + psA; mA = mnA; lB = lB * alB + psB; mB = mnB;
        u32x4 pwA, pwB;
        pwA.x = pk_bf16(sA[0], sA[1]); pwA.y = pk_bf16(sA[2], sA[3]); pwA.z = pk_bf16(sA[4], sA[5]); pwA.w = pk_bf16(sA[6], sA[7]);
        pwB.x = pk_bf16(sB[0], sB[1]); pwB.y = pk_bf16(sB[2], sB[3]); pwB.z = pk_bf16(sB[4], sB[5]); pwB.w = pk_bf16(sB[6], sB[7]);
        const bf16x8 pfA = __builtin_bit_cast(bf16x8, pwA), pfB = __builtin_bit_cast(bf16x8, pwB);
#pragma unroll
        for (int dt = 0; dt < 8; ++dt) { const bf16x8 vf = __builtin_bit_cast(bf16x8, vv[dt]);
            oA[dt] = oA[dt] * alA; oA[dt] = MFMA16(vf, pfA, oA[dt]); oB[dt] = oB[dt] * alB; oB[dt] = MFMA16(vf, pfB, oB[dt]); }
#pragma unroll
        for (int kk = 0; kk < 4; ++kk) { kc0[kk] = kn0[kk]; kc1[kk] = kn1[kk]; }
    }
    const float invA = 1.f / lA, invB = 1.f / lB;
    bf16_t* opA = MIX + (size_t)qrowA * 2048 + h * 128 + fq * 4; bf16_t* opB = MIX + (size_t)qrowB * 2048 + h * 128 + fq * 4;
#pragma unroll
    for (int dt = 0; dt < 8; ++dt) { u32x2 o; o.x = pk_bf16(oA[dt][0] * invA, oA[dt][1] * invA); o.y = pk_bf16(oA[dt][2] * invA, oA[dt][3] * invA); *(u32x2*)(opA + dt * 16) = o;
        u32x2 o2; o2.x = pk_bf16(oB[dt][0] * invB, oB[dt][1] * invB); o2.y = pk_bf16(oB[dt][2] * invB, oB[dt][3] * invB); *(u32x2*)(opB + dt * 16) = o2; }
}

__device__ __forceinline__ void xpose_wave_tile(const float* __restrict__ src, bf16_t* __restrict__ dst, int K, int N, int kt, int ntile, LAS unsigned* l32, int lane) {
    const int k0 = kt * 64, n0 = ntile * 64; const bool ok = (n0 + lane) < N;
    const float* sp = src + (size_t)k0 * N + n0 + lane;
#pragma unroll
    for (int hh = 0; hh < 2; ++hh) { float v[32];
#pragma unroll
        for (int i = 0; i < 32; ++i) v[i] = ok ? sp[(size_t)(hh * 32 + i) * N] : 0.f;
#pragma unroll
        for (int i = 0; i < 16; ++i) l32[lane * 33 + hh * 16 + i] = pk_bf16(v[2 * i], v[2 * i + 1]); }
    WAVE_LDS_SYNC();
#pragma unroll
    for (int j = 0; j < 8; ++j) { const int c = j * 64 + lane, row = c >> 3, chn = c & 7;
        u32x4 w; w.x = l32[row * 33 + chn * 4]; w.y = l32[row * 33 + chn * 4 + 1]; w.z = l32[row * 33 + chn * 4 + 2]; w.w = l32[row * 33 + chn * 4 + 3];
        *(u32x4*)(dst + (size_t)(n0 + row) * K + k0 + chn * 8) = w; }
    WAVE_LDS_SYNC();
}
__device__ __forceinline__ void xpose_item(const Params& p, int tile, LAS unsigned* l32, int lane) {
    const float* src; bf16_t* dst; int K, N, nkt;
    if (tile < 1024) { src = p.in[12]; dst = (bf16_t*)(p.ws + WS_WABOUT); K = 2048; N = 2048; nkt = 32; }
    else if (tile < 1280) { tile -= 1024; src = p.in[22]; dst = (bf16_t*)(p.ws + WS_WGLU); K = 1024; N = 1024; nkt = 16; }
    else if (tile < 5376) { tile -= 1280; src = p.in[8]; dst = (bf16_t*)(p.ws + WS_W1); K = 2048; N = 8192; nkt = 32; }
    else if (tile < 9472) { tile -= 5376; src = p.in[8] + (size_t)2048 * 8192; dst = (bf16_t*)(p.ws + WS_W1) + (size_t)8192 * 2048; K = 2048; N = 8192; nkt = 32; }
    else if (tile < 13568) { tile -= 9472; src = p.in[9]; dst = (bf16_t*)(p.ws + WS_W2); K = 8192; N = 2048; nkt = 128; }
    else if (tile < 17664) { tile -= 13568; src = p.in[9] + (size_t)8192 * 2048; dst = (bf16_t*)(p.ws + WS_W2) + (size_t)2048 * 8192; K = 8192; N = 2048; nkt = 128; }
    else if (tile < 20864) { tile -= 17664; src = p.in[24]; dst = (bf16_t*)(p.ws + WS_WGIN); K = 2048; N = 6176; nkt = 32; }
    else { tile -= 20864; src = p.in[28]; dst = (bf16_t*)(p.ws + WS_WGOUT); K = 2048; N = 2048; nkt = 32; }
    xpose_wave_tile(src, dst, K, N, tile % nkt, tile / nkt, l32, lane);
}

__device__ __forceinline__ void phase_mix0(const Params& p, LAS unsigned char* lds, int tid, int bid, int nblk) {
    const int wid = tid >> 6, lane = tid & 63;
    LAS float* RBL = (LAS float*)(lds + 51200);
    LAS unsigned* XL32 = (LAS unsigned*)(lds + 66560 + wid * 8448);
    for (int i = tid; i < 8 * 15 * 31; i += 512) RBL[i] = p.in[13][i];
    __syncthreads();
    if (wid < 4) { for (int sw = bid * 4 + wid; sw < 1024; sw += nblk * 4) s5_wave(p, sw, lds + wid * 12800, lane); }
    unsigned* ctr = (unsigned*)p.ws + 16;
    for (;;) { unsigned it = 0; if (lane == 0) it = atomicAdd(ctr, 1u); it = __builtin_amdgcn_readfirstlane(it); if (it >= 4608u + 2736u) break;
        if (it < 5472u) { if (it & 1u) { const int t0 = (int)(it >> 1) * 8; for (int j = 0; j < 8; ++j) xpose_item(p, t0 + j, XL32, lane); } else na_item(p, (int)(it >> 1), lane, RBL); }
        else na_item(p, (int)(it - 2736u), lane, RBL); }
}

__device__ __forceinline__ void phase_s5fin(const Params& p, int gt, int nt) {
    const bf16_t* P0 = (const bf16_t*)(p.ws + WS_PROJ0); const bf16_t* YF = (const bf16_t*)(p.ws + WS_YS5); const bf16_t* YB = YF + (size_t)MT * 1024;
    bf16_t* GL = (bf16_t*)(p.ws + WS_GL); const float* Dk = p.in[21];
    for (int i = gt; i < MT * 128; i += nt) { const int row = i >> 7, c8 = (i & 127) * 8;
        const u32x4 u = *(const u32x4*)(P0 + (size_t)row * P0LD + 3072 + c8), yf = *(const u32x4*)(YF + (size_t)row * 1024 + c8), yb = *(const u32x4*)(YB + (size_t)row * 1024 + c8);
        const f32x4 d0 = *(const f32x4*)(Dk + c8), d1 = *(const f32x4*)(Dk + c8 + 4);
        float v[8] = {bf_lo(yf.x) + bf_lo(yb.x) + d0[0] * bf_lo(u.x), bf_hi(yf.x) + bf_hi(yb.x) + d0[1] * bf_hi(u.x), bf_lo(yf.y) + bf_lo(yb.y) + d0[2] * bf_lo(u.y), bf_hi(yf.y) + bf_hi(yb.y) + d0[3] * bf_hi(u.y),
                      bf_lo(yf.z) + bf_lo(yb.z) + d1[0] * bf_lo(u.z), bf_hi(yf.z) + bf_hi(yb.z) + d1[1] * bf_hi(u.z), bf_lo(yf.w) + bf_lo(yb.w) + d1[2] * bf_lo(u.w), bf_hi(yf.w) + bf_hi(yb.w) + d1[3] * bf_hi(u.w)};
#pragma unroll
        for (int e = 0; e < 8; ++e) { const float x = v[e], t = __builtin_amdgcn_rcpf(fabsf(x) * 0.2316418882f + 1.0f);
            float q = t * 0.5307027145f + (-0.7265760135f); q = q * t + 0.7107068705f; q = q * t + (-0.142248368f); q = q * t + 0.127414796f; q = q * t;
            const float m = x * (q * __builtin_amdgcn_exp2f((x * x) * (-0.72134752044f))); v[e] = x < 0.f ? m : x - m; }
        u32x4 w; w.x = pk_bf16(v[0], v[1]); w.y = pk_bf16(v[2], v[3]); w.z = pk_bf16(v[4], v[5]); w.w = pk_bf16(v[6], v[7]);
        *(u32x4*)(GL + (size_t)row * 1024 + c8) = w; }
}

__device__ __forceinline__ void phase_glaprep(const Params& p, LAS unsigned char* lds, int tid, int bid, int nblk) {
    const bf16_t* QK = (const bf16_t*)(p.ws + WS_QK); const bf16_t* V1 = (const bf16_t*)(p.ws + WS_V1); const bf16_t* A1 = (const bf16_t*)(p.ws + WS_A1);
    bf16_t* QIN = (bf16_t*)(p.ws + WS_QIN); bf16_t* KIN = (bf16_t*)(p.ws + WS_KIN); bf16_t* KENDT = (bf16_t*)(p.ws + WS_KENDT); bf16_t* VT1 = (bf16_t*)(p.ws + WS_VT1);
    float* DEC = (float*)(p.ws + WS_DEC);
    LAS float* AC = (LAS float*)lds;
    LAS bf16_t* KE = (LAS bf16_t*)(lds + 8192);
    LAS bf16_t* QL = (LAS bf16_t*)(lds + 8192 + 67584);
    LAS bf16_t* KL = QL + 64 * 264;
    LAS float* HS = (LAS float*)(lds + 143360);
    for (int item = bid; item < 1152; item += nblk) {
        const int cid = item >> 2, h = item & 3; const int row0 = cid * 64; const bool lat = cid < 256;
        __syncthreads();
        { const int t = tid >> 3, c4 = (tid & 7) * 4; const u32x2 a = *(const u32x2*)(A1 + (size_t)(row0 + t) * 256 + c4);
          AC[t * 32 + c4] = bf_lo(a.x); AC[t * 32 + c4 + 1] = bf_hi(a.x); AC[t * 32 + c4 + 2] = bf_lo(a.y); AC[t * 32 + c4 + 3] = bf_hi(a.y); }
#pragma unroll
        for (int i = 0; i < 4; ++i) { const int piece = tid + i * 512, r = piece >> 5, c16 = piece & 31;
            const bf16_t* src = QK + (size_t)(row0 + r) * 2048 + h * 256 + c16 * 8;
            *(LAS u32x4*)(QL + r * 264 + c16 * 8) = *(const u32x4*)src;
            *(LAS u32x4*)(KL + r * 264 + c16 * 8) = *(const u32x4*)(src + 1024); }
        { const bf16_t* src = V1 + (size_t)row0 * 2048 + h * 512 + tid; LAS unsigned* vrow = (LAS unsigned*)(KE + tid * 66);
#pragma unroll
          for (int q = 0; q < 8; ++q) {
#pragma unroll
              for (int e = 0; e < 4; ++e) { const unsigned lo = src[(size_t)(q * 8 + 2 * e) * 2048], hi = src[(size_t)(q * 8 + 2 * e + 1) * 2048]; vrow[q * 4 + e] = lo | (hi << 16); } } }
        __syncthreads();
        { const int wv_ = tid >> 6, ln_ = tid & 63; bf16_t* dstb = VT1 + (size_t)(cid * 4 + h) * 512 * 64;
#pragma unroll
          for (int j = 0; j < 8; ++j) { const int row = wv_ * 64 + j * 8 + (ln_ >> 3), chn = ln_ & 7; const LAS unsigned* kr = (const LAS unsigned*)(KE + row * 66) + chn * 4;
              u32x4 o; o.x = kr[0]; o.y = kr[1]; o.z = kr[2]; o.w = kr[3]; *(u32x4*)(dstb + (size_t)row * 64 + chn * 8) = o; } }
        __syncthreads();
        const int dir = tid >> 8, th = (tid >> 7) & 1, dk0 = (tid & 127) * 2, ch = h * 256 + dk0, t0 = th * 32;
        float wa[16], wb[16];
#pragma unroll
        for (int r = 0; r < 16; ++r) { const f32x2 w2 = *(const f32x2*)(p.in[25] + (size_t)(dir * 16 + r) * 1024 + ch); wa[r] = w2.x; wb[r] = w2.y; }
        const f32x2 ba2 = *(const f32x2*)(p.in[26] + dir * 1024 + ch);
        LAS bf16_t* kela = KE + (dir * 256 + dk0) * 66 + t0;
        LAS bf16_t* kelb = kela + 66;
        float hs0 = 0.f, hs1 = 0.f;
#pragma unroll 4
        for (int tt = 0; tt < 32; ++tt) { const int t = t0 + tt; float z0 = ba2.x, z1 = ba2.y;
#pragma unroll
            for (int r4 = 0; r4 < 4; ++r4) { const f32x4 a = *(const LAS f32x4*)(AC + t * 32 + dir * 16 + r4 * 4);
                z0 += a[0] * wa[r4 * 4] + a[1] * wa[r4 * 4 + 1] + a[2] * wa[r4 * 4 + 2] + a[3] * wa[r4 * 4 + 3];
                z1 += a[0] * wb[r4 * 4] + a[1] * wb[r4 * 4 + 1] + a[2] * wb[r4 * 4 + 2] + a[3] * wb[r4 * 4 + 3]; }
            const _Float16 l0 = (_Float16)((fminf(z0, 0.f) - __logf(1.f + __expf(-fabsf(z0)))) * (1.f / 16.f));
            const _Float16 l1 = (_Float16)((fminf(z1, 0.f) - __logf(1.f + __expf(-fabsf(z1)))) * (1.f / 16.f));
            kela[tt] = __builtin_bit_cast(unsigned short, l0); kelb[tt] = __builtin_bit_cast(unsigned short, l1); hs0 += (float)l0; hs1 += (float)l1; }
        HS[tid * 2] = hs0; HS[tid * 2 + 1] = hs1;
        __syncthreads();
        const f32x2 oth = *(const LAS f32x2*)(HS + (tid ^ 128) * 2);
        const float blast0 = hs0 + oth.x, blast1 = hs1 + oth.y;
        const float eb0 = __expf(blast0), eb1 = __expf(blast1);
        if (th == 0) *(f32x2*)(DEC + (size_t)((dir * 288 + cid) * 4 + h) * 256 + dk0) = (f32x2){eb0, eb1};
        const int fi = dk0 & 63, halfsel = dk0 >> 7; const bool lowpart = (dk0 & 64) == 0;
        const float fr0 = exp2f(-(float)fi * (13.287712379549449f / 64.f)), fr1 = exp2f(-(float)(fi + 1) * (13.287712379549449f / 64.f));
        float cr0 = 1.f, sr0 = 0.f, cr1 = 1.f, sr1 = 0.f;
        if (lat) { const float rp = (float)(cid & 31); sr0 = __sinf(rp * fr0); cr0 = __cosf(rp * fr0); sr1 = __sinf(rp * fr1); cr1 = __cosf(rp * fr1); }
        bf16_t* qo = QIN + ((size_t)dir * MT + row0) * 1024 + ch; bf16_t* ko = KIN + ((size_t)dir * MT + row0) * 1024 + ch;
        float run0 = th ? oth.x : 0.f, run1 = th ? oth.y : 0.f;
        float cc0 = __cosf((float)t0 * fr0), sc0 = __sinf((float)t0 * fr0), cc1 = __cosf((float)t0 * fr1), sc1 = __sinf((float)t0 * fr1);
        const float cd0 = __cosf(fr0), sd0 = __sinf(fr0), cd1 = __cosf(fr1), sd1 = __sinf(fr1);
#pragma unroll 4
        for (int tt = 0; tt < 32; ++tt) { const int t = t0 + tt;
            const float la0 = (float)__builtin_bit_cast(_Float16, (unsigned short)kela[tt]), la1 = (float)__builtin_bit_cast(_Float16, (unsigned short)kelb[tt]);
            const float bc0 = dir ? (blast0 - run0) : (run0 + la0), bc1 = dir ? (blast1 - run1) : (run1 + la1);
            run0 += la0; run1 += la1;
            const unsigned qw = *(const LAS unsigned*)(QL + t * 264 + dk0), kw = *(const LAS unsigned*)(KL + t * 264 + dk0);
            float q0 = lat ? bf_lo(qw) * 0.0625f : 0.f, q1 = lat ? bf_hi(qw) * 0.0625f : 0.f, k0 = bf_lo(kw), k1 = bf_hi(kw);
            if (lat) { const unsigned qpw = *(const LAS unsigned*)(QL + t * 264 + (dk0 ^ 64)), kpw = *(const LAS unsigned*)(KL + t * 264 + (dk0 ^ 64));
                const float q2a = bf_lo(qpw) * 0.0625f, q2b = bf_hi(qpw) * 0.0625f, k2a = bf_lo(kpw), k2b = bf_hi(kpw);
                float c0 = cr0, s0 = sr0, c1 = cr1, s1 = sr1;
                if (halfsel) { s0 = sc0; c0 = cc0; s1 = sc1; c1 = cc1; }
                if (lowpart) { q0 = q0 * c0 - q2a * s0; k0 = k0 * c0 - k2a * s0; q1 = q1 * c1 - q2b * s1; k1 = k1 * c1 - k2b * s1; }
                else { q0 = q0 * c0 + q2a * s0; k0 = k0 * c0 + k2a * s0; q1 = q1 * c1 + q2b * s1; k1 = k1 * c1 + k2b * s1; } }
            const float e0 = __expf(bc0), e1 = __expf(bc1), ie0 = __builtin_amdgcn_rcpf(e0), ie1 = __builtin_amdgcn_rcpf(e1);
            const float ki0 = k0 * ie0, ki1 = k1 * ie1;
            *(unsigned*)(qo + (size_t)t * 1024) = pk_bf16(q0 * e0, q1 * e1);
            *(unsigned*)(ko + (size_t)t * 1024) = pk_bf16(ki0, ki1);
            const unsigned kew = pk_bf16(ki0 * eb0, ki1 * eb1);
            kela[tt] = (bf16_t)(kew & 0xffffu); kelb[tt] = (bf16_t)(kew >> 16);
            { const float nc0 = cc0 * cd0 - sc0 * sd0, ns0 = sc0 * cd0 + cc0 * sd0, nc1 = cc1 * cd1 - sc1 * sd1, ns1 = sc1 * cd1 + cc1 * sd1; cc0 = nc0; sc0 = ns0; cc1 = nc1; sc1 = ns1; }
        }
        __syncthreads();
        {
            const int wv_ = tid >> 6, ln_ = tid & 63;
#pragma unroll
            for (int j = 0; j < 8; ++j) { const int row = wv_ * 64 + j * 8 + (ln_ >> 3), chn = ln_ & 7; const LAS unsigned* kr = (const LAS unsigned*)(KE + row * 66) + chn * 4;
                bf16_t* keo = KENDT + ((size_t)(((row >> 8) * 288 + cid) * 4 + h) * 256 + (row & 255)) * 64 + chn * 8;
                u32x4 o; o.x = kr[0]; o.y = kr[1]; o.z = kr[2]; o.w = kr[3]; *(u32x4*)keo = o; } }
    }
}

__device__ __forceinline__ void phase_glascan(const Params& p, LAS unsigned char* lds, int tid, int bid, int nblk) {
    const bf16_t* QIN = (const bf16_t*)(p.ws + WS_QIN); const bf16_t* KIN = (const bf16_t*)(p.ws + WS_KIN); const bf16_t* KENDT = (const bf16_t*)(p.ws + WS_KENDT);
    const bf16_t* VT1 = (const bf16_t*)(p.ws + WS_VT1); const float* DEC = (const float*)(p.ws + WS_DEC);
    const int wid = tid >> 6, lane = tid & 63, fr = lane & 15, fq = lane >> 4;
    LAS unsigned char* QL = lds;
    LAS unsigned char* KL = lds + 33792;
    LAS unsigned char* EL = lds + 67584;
    LAS unsigned char* AL = lds + 104448;
    LAS float* DL = (LAS float*)(lds + 113664);
    const f32x4 z4 = {0.f, 0.f, 0.f, 0.f};
    for (int item = bid; item < 256; item += nblk) {
        const int seq = item >> 3, dir = (item >> 2) & 1, dvs = item & 3, b = seq >> 2, h = seq & 3;
        const int dv0 = dvs * 128 + wid * 16;
        bf16_t* OFB = (bf16_t*)(p.ws + (dir ? WS_V1 : WS_QK));
        f32x4 S[16];
#pragma unroll
        for (int kt = 0; kt < 16; ++kt) S[kt] = z4;
        auto cid_of = [&](int n_) { const bool lt = n_ >= 4; return dir == 0 ? (lt ? b * 32 + (n_ - 4) : 256 + b * 4 + n_) : (lt ? b * 32 + 31 - (n_ - 4) : 256 + b * 4 + 3 - n_); };
        u32x4 rq[4], rk[4], re[4]; float rd = 0.f; bf16x8 rv[2];
        auto fetch = [&](int n_) { const int cid_ = cid_of(n_); const int row0_ = cid_ * 64; const size_t cb_ = (size_t)((dir * 288 + cid_) * 4 + h);
            if (n_ >= 4) {
#pragma unroll
                for (int i = 0; i < 4; ++i) { const int piece = tid + i * 512, r = piece >> 5, c16 = piece & 31;
                    const size_t go = ((size_t)dir * MT + row0_ + r) * 1024 + h * 256 + c16 * 8;
                    rq[i] = *(const u32x4*)(QIN + go); rk[i] = *(const u32x4*)(KIN + go); } }
#pragma unroll
            for (int i = 0; i < 4; ++i) { const int piece = tid + i * 512, r = piece >> 3, c16 = piece & 7;
                re[i] = *(const u32x4*)(KENDT + (cb_ * 256 + r) * 64 + c16 * 8); }
            if (tid < 256) rd = DEC[cb_ * 256 + tid];
#pragma unroll
            for (int ts = 0; ts < 2; ++ts) rv[ts] = *(const bf16x8*)(VT1 + ((size_t)(cid_ * 4 + h) * 512 + dv0 + fr) * 64 + ts * 32 + fq * 8); };
        fetch(0);
        for (int n = 0; n < 36; ++n) {
            const bool lat = n >= 4;
            const int cid = cid_of(n);
            const int row0 = cid * 64;
            __syncthreads();
            if (lat) {
#pragma unroll
                for (int i = 0; i < 4; ++i) { const int piece = tid + i * 512, r = piece >> 5, c16 = piece & 31;
                    *(LAS u32x4*)(QL + r * 528 + c16 * 16) = rq[i]; *(LAS u32x4*)(KL + r * 528 + c16 * 16) = rk[i]; }
            }
#pragma unroll
            for (int i = 0; i < 4; ++i) { const int piece = tid + i * 512, r = piece >> 3, c16 = piece & 7; *(LAS u32x4*)(EL + r * 144 + c16 * 16) = re[i]; }
            if (tid < 256) DL[tid] = rd;
            bf16x8 vf[2]; vf[0] = rv[0]; vf[1] = rv[1];
            __syncthreads();
            if (n + 1 < 36) fetch(n + 1);
            if (lat) {
                const int tit = wid >> 1;
#pragma unroll
                for (int jj2 = 0; jj2 < 2; ++jj2) { const int jt = 2 * (wid & 1) + jj2;
                    const bool need = dir == 0 ? (jt <= tit) : (jt >= tit);
                    f32x4 a = z4;
                    if (need) {
#pragma unroll
                        for (int kk = 0; kk < 8; ++kk) { const bf16x8 kf = *(const LAS bf16x8*)(KL + (jt * 16 + fr) * 528 + (kk * 32 + fq * 8) * 2), qf = *(const LAS bf16x8*)(QL + (tit * 16 + fr) * 528 + (kk * 32 + fq * 8) * 2);
                            a = MFMA16(kf, qf, a); }
                        const int ti = tit * 16 + fr;
#pragma unroll
                        for (int e = 0; e < 4; ++e) { const int tj = jt * 16 + fq * 4 + e; const bool keep = dir == 0 ? (tj <= ti) : (tj >= ti); a[e] = keep ? a[e] : 0.f; }
                    }
                    u32x2 w; w.x = pk_bf16(a[0], a[1]); w.y = pk_bf16(a[2], a[3]);
                    *(LAS u32x2*)(AL + (tit * 16 + fr) * 144 + (jt * 16 + fq * 4) * 2) = w; }
                f32x4 O[4] = {z4, z4, z4, z4};
#pragma unroll
                for (int kp = 0; kp < 8; ++kp) { u32x4 sw; sw.x = pk_bf16(S[2 * kp][0], S[2 * kp][1]); sw.y = pk_bf16(S[2 * kp][2], S[2 * kp][3]); sw.z = pk_bf16(S[2 * kp + 1][0], S[2 * kp + 1][1]); sw.w = pk_bf16(S[2 * kp + 1][2], S[2 * kp + 1][3]);
                    const bf16x8 sA = __builtin_bit_cast(bf16x8, sw);
#pragma unroll
                    for (int tt = 0; tt < 4; ++tt) { const u32x2 lo = *(const LAS u32x2*)(QL + (tt * 16 + fr) * 528 + (kp * 32 + fq * 4) * 2), hi = *(const LAS u32x2*)(QL + (tt * 16 + fr) * 528 + (kp * 32 + 16 + fq * 4) * 2);
                        u32x4 qw; qw.x = lo.x; qw.y = lo.y; qw.z = hi.x; qw.w = hi.y;
                        O[tt] = MFMA16(sA, __builtin_bit_cast(bf16x8, qw), O[tt]); } }
                __syncthreads();
#pragma unroll
                for (int tt = 0; tt < 4; ++tt) {
#pragma unroll
                    for (int ts = 0; ts < 2; ++ts) { const bf16x8 ab = *(const LAS bf16x8*)(AL + (tt * 16 + fr) * 144 + (ts * 32 + fq * 8) * 2); O[tt] = MFMA16(vf[ts], ab, O[tt]); }
                    u32x2 o; o.x = pk_bf16(O[tt][0], O[tt][1]); o.y = pk_bf16(O[tt][2], O[tt][3]);
                    *(u32x2*)(OFB + (size_t)(row0 + tt * 16 + fr) * 2048 + h * 512 + dv0 + fq * 4) = o; }
            }
#pragma unroll
            for (int kt = 0; kt < 16; ++kt) { const f32x4 d4 = *(const LAS f32x4*)(DL + kt * 16 + fq * 4); S[kt] = S[kt] * d4;
#pragma unroll
                for (int ts = 0; ts < 2; ++ts) { const bf16x8 kf = *(const LAS bf16x8*)(EL + (kt * 16 + fr) * 144 + (ts * 32 + fq * 8) * 2); S[kt] = MFMA16(kf, vf[ts], S[kt]); } }
        }
    }
}

__device__ __forceinline__ void phase_glafin(const Params& p, int gw, int nw, int lane) {
    const bf16_t* OF = (const bf16_t*)(p.ws + WS_QK); const bf16_t* OB = (const bf16_t*)(p.ws + WS_V1); const bf16_t* G1 = (const bf16_t*)(p.ws + WS_G1);
    bf16_t* MIX = (bf16_t*)(p.ws + WS_MIX); const float* NG = p.in[27];
    auto offof = [&](int it_) { return (size_t)(it_ >> 2) * 2048 + (it_ & 3) * 512 + lane * 8; };
    u32x4 a = {0u, 0u, 0u, 0u}, bb = a, g = a; size_t off = 0;
    if (gw < ML * 4) { off = offof(gw); a = *(const u32x4*)(OF + off); bb = *(const u32x4*)(OB + off); g = *(const u32x4*)(G1 + off); }
    for (int it = gw; it < ML * 4; it += nw) {
        u32x4 an = a, bn = bb, gn = g; size_t offn = off;
        if (it + nw < ML * 4) { offn = offof(it + nw); an = *(const u32x4*)(OF + offn); bn = *(const u32x4*)(OB + offn); gn = *(const u32x4*)(G1 + offn); }
        float o[8] = {bf_lo(a.x) + bf_lo(bb.x), bf_hi(a.x) + bf_hi(bb.x), bf_lo(a.y) + bf_lo(bb.y), bf_hi(a.y) + bf_hi(bb.y), bf_lo(a.z) + bf_lo(bb.z), bf_hi(a.z) + bf_hi(bb.z), bf_lo(a.w) + bf_lo(bb.w), bf_hi(a.w) + bf_hi(bb.w)};
        float gg[8] = {bf_lo(g.x), bf_hi(g.x), bf_lo(g.y), bf_hi(g.y), bf_lo(g.z), bf_hi(g.z), bf_lo(g.w), bf_hi(g.w)};
        float ss = 0.f;
#pragma unroll
        for (int e = 0; e < 8; ++e) ss += o[e] * o[e];
        ss = wave_sum(ss);
        const float rstd = rsqrtf(ss * (1.f / 512.f) + 1e-6f);
        const f32x4 n0 = *(const f32x4*)(NG + lane * 8), n1 = *(const f32x4*)(NG + lane * 8 + 4);
        float r[8];
#pragma unroll
        for (int e = 0; e < 8; ++e) { const float ng = e < 4 ? n0[e & 3] : n1[e & 3]; r[e] = o[e] * rstd * ng * (gg[e] / (1.f + __expf(-gg[e]))); }
        u32x4 w; w.x = pk_bf16(r[0], r[1]); w.y = pk_bf16(r[2], r[3]); w.z = pk_bf16(r[4], r[5]); w.w = pk_bf16(r[6], r[7]);
        *(u32x4*)(MIX + off) = w;
        a = an; bb = bn; g = gn; off = offn; }
}


#define XB_TMO      128
#define XB_XCNT(j)  (256  + 64 * (j))
#define XB_XSUB(j)  (1280 + 64 * (j))
#define XB_XGEN(j)  (2304 + 64 * (j))
#define XB_TOP      3328
#define XB_TOPGEN   3392
#define XCD_BAR_WORDS 3456
#define XB_SPIN_CAP (1u << 18)

__device__ __forceinline__ unsigned xb_ld(unsigned* p)              { return __hip_atomic_load(p, __ATOMIC_RELAXED, __HIP_MEMORY_SCOPE_AGENT); }
__device__ __forceinline__ unsigned xb_add(unsigned* p, unsigned v) { return __hip_atomic_fetch_add(p, v, __ATOMIC_RELAXED, __HIP_MEMORY_SCOPE_AGENT); }
__device__ __forceinline__ unsigned xb_xcc_id() { return (unsigned)__builtin_amdgcn_s_getreg((3 << 11) | 20) & 0xFu; }
#define XB_SPIN(cond, bar) do { unsigned _sp = 0; while (cond) { __builtin_amdgcn_s_sleep(1); \
    if ((++_sp & 255u) == 0u) { if (xb_ld(&(bar)[XB_TMO])) break; if (_sp > XB_SPIN_CAP) { atomicAdd(&(bar)[XB_TMO], 1u); break; } } } } while (0)

struct XcdBarrier {
    unsigned* bar; unsigned x;
    volatile LAS unsigned* st;
};

__device__ __forceinline__ XcdBarrier xcd_barrier_post(unsigned* bar, volatile LAS unsigned* st) {
    XcdBarrier b; b.bar = bar; b.x = xb_xcc_id(); b.st = st;
    if (threadIdx.x == 0) (void)xb_add(&bar[XB_XCNT(b.x)], 1u);
    return b;
}
__device__ __forceinline__ void xcd_barrier_complete(unsigned* bar, unsigned x, unsigned& nloc, unsigned& nx) {
    const unsigned G = gridDim.x * gridDim.y * gridDim.z;
    unsigned sum, cnt, mine, sp = 0u;
    for (;;) {
        sum = 0u; cnt = 0u; mine = 0u;
#pragma unroll
        for (unsigned j = 0; j < 16; ++j) { const unsigned c = xb_ld(&bar[XB_XCNT(j)]); sum += c; cnt += (c > 0u) ? 1u : 0u; mine = (j == x) ? c : mine; }
        if (sum == G) break;
        __builtin_amdgcn_s_sleep(1);
        if ((++sp & 255u) == 0u) { if (xb_ld(&bar[XB_TMO])) break; if (sp > XB_SPIN_CAP) { atomicAdd(&bar[XB_TMO], 1u); break; } }
    }
    nloc = mine > 0u ? mine : 1u; nx = cnt > 0u ? cnt : 1u;
}

__device__ __forceinline__ void xcd_barrier(const XcdBarrier& b) {
    asm volatile("s_waitcnt vmcnt(0)" ::: "memory");
    __syncthreads();
    if (threadIdx.x == 0) {
        unsigned* bar = b.bar;
        __builtin_amdgcn_s_waitcnt(0);
        unsigned nloc = b.st[0], nx = b.st[1];
        if (nloc == 0u) { xcd_barrier_complete(bar, b.x, nloc, nx); b.st[0] = nloc; b.st[1] = nx; }
        const unsigned old = xb_add(&bar[XB_XSUB(b.x)], 1u);
        const unsigned gen = old / nloc;
        if (old + 1u == (gen + 1u) * nloc) {
            __builtin_amdgcn_fence(__ATOMIC_RELEASE, "agent");
            asm volatile("s_waitcnt vmcnt(0)" ::: "memory");
            const unsigned og = xb_add(&bar[XB_TOP], 1u);
            const unsigned tg = og / nx;
            if (og + 1u == (tg + 1u) * nx) xb_add(&bar[XB_TOPGEN], 1u);
            else XB_SPIN(xb_ld(&bar[XB_TOPGEN]) == tg, bar);
            __builtin_amdgcn_fence(__ATOMIC_ACQUIRE, "agent");
            xb_add(&bar[XB_XGEN(b.x)], 1u);
            asm volatile("s_waitcnt vmcnt(0)" ::: "memory");
        } else {
            XB_SPIN(xb_ld(&bar[XB_XGEN(b.x)]) == gen, bar);
            __builtin_amdgcn_fence(__ATOMIC_ACQUIRE, "agent");
            asm volatile("s_waitcnt vmcnt(0)" ::: "memory");
        }
    }
    __syncthreads();
}

__global__ void __launch_bounds__(512, 2) fwd_mega(Params p) {
    extern __shared__ __attribute__((aligned(16))) unsigned char smem[];
    LAS unsigned char* lds = (LAS unsigned char*)smem;
    cg::grid_group grid = cg::this_grid();
    const int tid = threadIdx.x, bid = blockIdx.x, nblk = gridDim.x, wid = tid >> 6, lane = tid & 63;
    const int gw = bid * 8 + wid, nw = nblk * 8;
    unsigned char* ws = p.ws;
    float* mod = (float*)(ws + WS_MOD);
    float* XL = p.out; float* XC = (float*)(ws + WS_XC);
    bf16_t* H = (bf16_t*)(ws + WS_H); bf16_t* MIX = (bf16_t*)(ws + WS_MIX);
#define RUN(k) (p.ph_lo <= (k) && (k) < p.ph_hi)
#define SYNC(k) do { if (p.ph_lo <= (k) && (k) + 1 < p.ph_hi) xcd_barrier(xbar); } while (0)
#define GEMM_BF16(k, Aop, Bop, Mv, Nv, Kv, EB) do { if (RUN(k)) { const pg8::Gemm g{(Aop), (Bop), (Mv), (Nv), (Kv), 0}; pg8::StaticOrder S; S.init(g.M, g.N, nblk, bid); __syncthreads(); \
        pg8::gemm_phase<EpiBf16S, pg8::StaticOrder, true, true>(lds, g, S, (EB)); } SYNC(k); } while (0)
#define GEMM_RES(k, Aop, Bop, Mv, Nv, Kv, ER) do { if (RUN(k)) { const pg8::Gemm g{(Aop), (Bop), (Mv), (Nv), (Kv), 0}; pg8::StaticOrder S; S.init(g.M, g.N, nblk, bid); __syncthreads(); \
        pg8::gemm_phase<EpiResid, pg8::StaticOrder, true, true>(lds, g, S, (ER)); } SYNC(k); } while (0)
    volatile LAS unsigned* xst = (volatile LAS unsigned*)(lds + LDS_BYTES - 16);
    if (tid == 0) { xst[0] = 0u; xst[1] = 0u; }
    __syncthreads();
    XcdBarrier xbar = xcd_barrier_post((unsigned*)(ws + 4096), xst);
    if (p.ph_hi - p.ph_lo > 1) grid.sync();
    if (RUN(0)) phase_prep(p, lds, tid, bid, nblk);
    SYNC(0);
    if (RUN(1)) phase_norm(p.in[0], p.in[2], p.in[6], mod, 0, 2048, H, MT, gw, nw, lane);
    SYNC(1);
    GEMM_BF16(2, H, (const bf16_t*)(ws + WS_WABIN), MT, 4096, 2048, (EpiBf16S{(bf16_t*)(ws + WS_PROJ0), nullptr, nullptr, nullptr, P0LD, 0, 1 << 30, 0}));
    if (RUN(3)) phase_vt0(p, tid, bid, nblk);
    SYNC(3);
    if (RUN(4)) phase_mix0(p, lds, tid, bid, nblk);
    SYNC(4);
    if (RUN(5)) phase_s5fin(p, bid * 512 + tid, nblk * 512);
    SYNC(5);
    if (RUN(6)) { const pg8::Gemm g{(const bf16_t*)(ws + WS_GL), (const bf16_t*)(ws + WS_WGLU), MT, 1024, 1024, 0}; pg8::StaticOrder S; S.init(g.M, g.N, nblk, bid); __syncthreads();
        EpiGlu eg{(const bf16_t*)(ws + WS_GL), p.in[23], MIX}; pg8::gemm_phase<EpiGlu, pg8::StaticOrder, true, true>(lds, g, S, eg); }
    SYNC(6);
    GEMM_RES(7, MIX, (const bf16_t*)(ws + WS_WABOUT), MT, 2048, 2048, (EpiResid{p.in[0], p.in[2], XL, XC, mod + 4096}));
    if (RUN(8)) phase_norm(XL, XC, p.in[7], mod, 6144, 8192, H, MT, gw, nw, lane);
    SYNC(8);
    GEMM_BF16(9, H, (const bf16_t*)(ws + WS_W1), MT, 8192, 2048, (EpiBf16S{(bf16_t*)(ws + WS_HID), nullptr, nullptr, nullptr, 8192, 0, 1 << 30, 1}));
    if (RUN(10)) { { const pg8::Gemm g{(const bf16_t*)(ws + WS_HID), (const bf16_t*)(ws + WS_W2), ML, 2048, 8192, 0}; pg8::StaticOrder S; S.init(g.M, g.N, nblk, bid); __syncthreads();
          pg8::gemm_phase<EpiResid, pg8::StaticOrder, true, true>(lds, g, S, (EpiResid{XL, XC, XL, XC, mod + 10240})); }
        { const pg8::Gemm g{(const bf16_t*)(ws + WS_HID), (const bf16_t*)(ws + WS_W2), MT, 2048, 8192, 2048}; SplitOrder S{nblk, bid}; __syncthreads();
          pg8::gemm_phase<EpiPart, SplitOrder, true, true>(lds, g, S, (EpiPart{(float*)(ws + WS_PART)})); } }
    SYNC(10);
    if (RUN(11)) phase_norm(XL, XC, p.in[6] + 2048, mod + 9 * 12288, 0, 2048, H, MT, gw, nw, lane, (const float*)(ws + WS_PART), mod + 8 * 12288 + 10240);
    SYNC(11);
    if (RUN(12)) { const pg8::Gemm g{H, (const bf16_t*)(ws + WS_WGIN), MT, 6400, 2048, 0}; Proj1Order S; S.init(nblk, bid); __syncthreads();
        pg8::gemm_phase<EpiBf16S, Proj1Order, true, true>(lds, g, S, (EpiBf16S{(bf16_t*)(ws + WS_QK), (bf16_t*)(ws + WS_V1), (bf16_t*)(ws + WS_G1), (bf16_t*)(ws + WS_A1), 2048, 256, 2048, 0})); }
    SYNC(12);
    if (RUN(13)) phase_glaprep(p, lds, tid, bid, nblk);
    SYNC(13);
    if (RUN(14)) phase_glascan(p, lds, tid, bid, nblk);
    SYNC(14);
    if (RUN(15)) phase_glafin(p, gw, nw, lane);
    SYNC(15);
    GEMM_RES(16, MIX, (const bf16_t*)(ws + WS_WGOUT), ML, 2048, 2048, (EpiResid{XL, XC, XL, XC, mod + 9 * 12288 + 4096}));
    if (RUN(17)) phase_norm(XL, XC, p.in[7] + 2048, mod + 9 * 12288, 6144, 8192, H, ML, gw, nw, lane);
    SYNC(17);
    GEMM_BF16(18, H, (const bf16_t*)(ws + WS_W1) + (size_t)8192 * 2048, ML, 8192, 2048, (EpiBf16S{(bf16_t*)(ws + WS_HID), nullptr, nullptr, nullptr, 8192, 0, 1 << 30, 1}));
    GEMM_RES(19, (const bf16_t*)(ws + WS_HID), (const bf16_t*)(ws + WS_W2) + (size_t)2048 * 8192, ML, 2048, 8192, (EpiResid{XL, XC, XL, XC, mod + 9 * 12288 + 10240}));
    if (RUN(20)) phase_final_norm(XL, p.in[10], gw, nw, lane);
}

extern "C" void kernel_launch(void* const* d_in, const int* in_sizes, int n_in, void* d_out, int out_size, void* d_ws, size_t ws_size, hipStream_t stream) {
    static int grid = 0;
    if (grid == 0) {
        if (n_in != 29 || ws_size < WS_END) { fprintf(stderr, "kernel_launch: need 29 inputs and %zu bytes of workspace; got %d, %zu\n", (size_t)WS_END, n_in, ws_size); grid = -1; return; }
        int dev = 0, cus = 0, per_cu = 0;
        hipGetDevice(&dev); hipDeviceGetAttribute(&cus, hipDeviceAttributeMultiprocessorCount, dev);
        if (hipFuncSetAttribute((const void*)fwd_mega, hipFuncAttributeMaxDynamicSharedMemorySize, LDS_BYTES) != hipSuccess) { fprintf(stderr, "kernel_launch: hipFuncSetAttribute failed\n"); grid = -1; return; }
        hipOccupancyMaxActiveBlocksPerMultiprocessor(&per_cu, (const void*)fwd_mega, 512, LDS_BYTES);
        if (per_cu < 1) per_cu = 1;
        (void)hipGetLastError();
        grid = cus * per_cu;
        if (grid > 256) grid = 256;
    }
    if (grid < 0) return;
    (void)hipMemsetAsync(d_ws, 0, 32768, stream);
    Params p{};
    for (int i = 0; i < 29; ++i) p.in[i] = (const float*)d_in[i];
    p.out = (float*)d_out; p.ws = (unsigned char*)d_ws;
#ifndef MK_MULTI
    p.ph_lo = 0; p.ph_hi = NPH;
    void* args[] = {&p};
    hipError_t e = hipLaunchCooperativeKernel((const void*)fwd_mega, dim3(grid), dim3(512), args, LDS_BYTES, stream);
    if (e != hipSuccess) fprintf(stderr, "cooperative launch failed: %s (grid %d)\n", hipGetErrorString(e), grid);
#else
    for (int ph = 0; ph < NPH; ++ph) { p.ph_lo = ph; p.ph_hi = ph + 1; hipLaunchKernelGGL(fwd_mega, dim3(grid), dim3(512), LDS_BYTES, stream, p); }
#endif
}
```

```cpp
#include <hip/hip_runtime.h>
#include <hip/hip_cooperative_groups.h>
#include <cstdio>
#include <cstdint>
namespace cg = cooperative_groups;
namespace pg8 {
#define PG8_LAS __attribute__((address_space(3)))
typedef unsigned short bf16_t;
typedef short bf16x8 __attribute__((ext_vector_type(8)));
typedef float f32x4 __attribute__((ext_vector_type(4)));
typedef unsigned u32x4 __attribute__((ext_vector_type(4)));
constexpr int BM = 256, BK = 64, HALF = 128, HTB = HALF * BK * 2  , STAGE_BYTES = 8 * HTB, NXCD = 8, WGM = 8;

__host__ __device__ __forceinline__ int lds_byte(int r, int c) { const int st = (r >> 4) * 2 + (c >> 5), rr = r & 15, cc = c & 31, ob = rr * 64 + cc * 2; return st * 1024 + (ob ^ (((ob >> 9) & 1) << 5)); }
__host__ __device__ __forceinline__ void stage_rc(int b, int& R, int& C) { const int st = b / 1024, sb = b % 1024, swz = sb ^ (((sb >> 9) & 1) << 5); R = (st >> 1) * 16 + swz / 64; C = (st & 1) * 32 + (swz % 64) / 2; }
__host__ __device__ __forceinline__ int perm32(int rho) { const int n = rho >> 4, i = rho & 15; return 8 * (i >> 2) + 4 * n + (i & 3); }

struct Unit { int pm, pn, ks; };
struct Gemm { const bf16_t* A; const bf16_t* Bt; int M, N, K, KL; };

struct StaticOrder {
    int nM, nN, nwg, G, c;
    __host__ __device__ void init(int M, int N, int G_, int c_) { nM = M / BM; nN = N / BM; nwg = nM * nN; G = G_; c = c_; }
    __host__ __device__ bool next(int i, Unit& u) const {
        const long L = (long)i * G + c; if (L >= nwg) return false;
        int wgid = (int)L; { const int q = nwg / NXCD, r = nwg % NXCD, xcd = wgid % NXCD, off = wgid / NXCD; wgid = (xcd < r ? xcd * (q + 1) : r * (q + 1) + (xcd - r) * q) + off; }
        const int nig = WGM * nN, gid = wgid / nig, fm = gid * WGM, gsz = (nM - fm) < WGM ? (nM - fm) : WGM;
        u.pm = fm + ((wgid % nig) % gsz); u.pn = (wgid % nig) / gsz; u.ks = 0; return true;
    }
    __device__ __forceinline__ void a_ready(const Unit&) const {}
    __device__ __forceinline__ void done(const Unit&) const {}
};
typedef __bf16 bf16v2_t0 __attribute__((ext_vector_type(2))); typedef float f32x2_t0 __attribute__((ext_vector_type(2)));
__device__ __forceinline__ unsigned cvt_pk_bf16(float lo, float hi) { const f32x2_t0 f = {lo, hi}; const bf16v2_t0 v = __builtin_convertvector(f, bf16v2_t0); return __builtin_bit_cast(unsigned, v); }
template <class Epi, class Sched, bool ALIGN_EPI = false, bool SP2 = false>
__device__ __forceinline__ void gemm_phase(PG8_LAS unsigned char* lds, const Gemm g, const Sched& S, const Epi& E) {
    const int tid = threadIdx.x, wid = __builtin_amdgcn_readfirstlane(tid >> 6), lane = tid & 63, wr = wid >> 2, wc = wid & 3, fr = lane & 15, fq = lane >> 4;
    const int K = g.K, nt = (g.KL ? g.KL : g.K) / BK; const size_t kspan = (size_t)g.KL * 2;
    unsigned voffA[2], voffB[2];
#pragma unroll
    for (int i = 0; i < 2; ++i) { int R, C; stage_rc(tid * 16 + i * 8192, R, C); const int Rb = Epi::PERM ? ((R & ~31) + perm32(R & 31)) : R;
        voffA[i] = (unsigned)(R * K + C) * 2u; voffB[i] = (unsigned)(Rb * K + C) * 2u; }
    const size_t kstep = (size_t)(BK * 2);
    const size_t hstep = (size_t)HALF * K * 2;
    const size_t tstep = 2 * hstep;
    const unsigned ldsw = (unsigned)wid * 1024u;
    const int aoff = lds_byte(wr * 64 + fr, fq * 8), boff = lds_byte(wc * 32 + fr, fq * 8);
#define PG8_SA(b, h) (((b) * 2 + (h)) * HTB)
#define PG8_SB(b, h) ((4 + (b) * 2 + (h)) * HTB)
#define PG8_STAGE(bufoff, gbase, voff) do { _Pragma("unroll") for (int _i = 0; _i < 2; ++_i) \
        __builtin_amdgcn_global_load_lds((const unsigned*)((const char*)(gbase) + (voff)[_i]), (PG8_LAS unsigned*)(lds + (bufoff) + ldsw + _i * 8192), 16, 0, 0); } while (0)
#define PG8_LDA(dst, b, h) do { _Pragma("unroll") for (int m = 0; m < 4; ++m) _Pragma("unroll") for (int k = 0; k < 2; ++k) dst[m][k] = *(const PG8_LAS bf16x8*)(lds + PG8_SA(b, h) + aoff + m * 2048 + k * 1024); } while (0)
#define PG8_LDB(dst, b, h) do { _Pragma("unroll") for (int n = 0; n < 2; ++n) _Pragma("unroll") for (int k = 0; k < 2; ++k) dst[n][k] = *(const PG8_LAS bf16x8*)(lds + PG8_SB(b, h) + boff + n * 2048 + k * 1024); } while (0)
#define PG8_MMA(ai, bj, At, Bt) do { __builtin_amdgcn_s_setprio(1); _Pragma("unroll") for (int m = 0; m < 4; ++m) _Pragma("unroll") for (int n = 0; n < 2; ++n) _Pragma("unroll") for (int k = 0; k < 2; ++k) \
        acc[ai][bj][m][n] = __builtin_amdgcn_mfma_f32_16x16x32_bf16(Bt[n][k], At[m][k], acc[ai][bj][m][n], 0, 0, 0); __builtin_amdgcn_s_setprio(0); } while (0)
#define PG8_WAIT_V(n) asm volatile("s_waitcnt vmcnt(" #n ")" ::: "memory")
#define PG8_WAIT_L(n) asm volatile("s_waitcnt lgkmcnt(" #n ")" ::: "memory")
#define PG8_BAR __builtin_amdgcn_s_barrier()
#define PG8_SCHED __builtin_amdgcn_sched_barrier(0)
    Unit cur, nxt; int ui = 0;
    if (!S.next(0, cur)) return;
    f32x4 acc[2][2][4][2];
#pragma unroll
    for (int a = 0; a < 2; ++a)
#pragma unroll
        for (int b = 0; b < 2; ++b)
#pragma unroll
            for (int m = 0; m < 4; ++m)
#pragma unroll
                for (int n = 0; n < 2; ++n) acc[a][b][m][n] = (f32x4){0.f, 0.f, 0.f, 0.f};
    bf16x8 At[4][2], B0[2][2], B1[2][2];
    const char* cA = (const char*)g.A + (size_t)cur.pm * tstep + (size_t)cur.ks * kspan; const char* cB = (const char*)g.Bt + (size_t)cur.pn * tstep + (size_t)cur.ks * kspan;
    S.a_ready(cur);
    if constexpr (SP2) {
        PG8_STAGE(PG8_SB(0, 0), cB, voffB); PG8_STAGE(PG8_SB(0, 1), cB + hstep, voffB); PG8_STAGE(PG8_SA(0, 0), cA, voffA); PG8_STAGE(PG8_SA(0, 1), cA + hstep, voffA);
        if (wr == 1) PG8_BAR;
        PG8_WAIT_V(2); PG8_BAR;
        PG8_STAGE(PG8_SB(1, 0), cB + kstep, voffB); PG8_STAGE(PG8_SA(1, 0), cA + kstep, voffA); PG8_STAGE(PG8_SB(1, 1), cB + hstep + kstep, voffB);
        PG8_WAIT_V(6); PG8_BAR;
    } else {
        PG8_STAGE(PG8_SB(0, 0), cB, voffB); PG8_STAGE(PG8_SA(0, 0), cA, voffA); PG8_STAGE(PG8_SB(0, 1), cB + hstep, voffB); PG8_STAGE(PG8_SA(0, 1), cA + hstep, voffA);
        if (wr == 1) PG8_BAR;
        PG8_WAIT_V(4); PG8_BAR;
        PG8_STAGE(PG8_SB(1, 0), cB + kstep, voffB); PG8_STAGE(PG8_SA(1, 0), cA + kstep, voffA); PG8_STAGE(PG8_SB(1, 1), cB + hstep + kstep, voffB);
        PG8_WAIT_V(6); PG8_BAR;
    }
    for (;;) {
        const bool has_next = S.next(ui + 1, nxt);
        const char* nA = has_next ? (const char*)g.A + (size_t)nxt.pm * tstep + (size_t)nxt.ks * kspan : cA; const char* nB = has_next ? (const char*)g.Bt + (size_t)nxt.pn * tstep + (size_t)nxt.ks * kspan : cB;
        for (int t = 0; t < nt; t += 2) {
            const bool last = (t == nt - 2);
            const char* a1 = cA + (size_t)(t + 1) * kstep;
            const char* a2 = last ? nA : cA + (size_t)(t + 2) * kstep; const char* b2 = last ? nB : cB + (size_t)(t + 2) * kstep;
            const char* a3 = a2 + kstep; const char* b3 = b2 + kstep;
            if (last && has_next) S.a_ready(nxt);
            if constexpr (SP2) {
            PG8_LDB(B0, 0, 0); PG8_LDB(B1, 0, 1); PG8_SCHED; PG8_LDA(At, 0, 0); PG8_STAGE(PG8_SA(1, 1), a1 + hstep, voffA);
            PG8_WAIT_V(8); PG8_WAIT_L(0); PG8_BAR; PG8_MMA(0, 0, At, B0); PG8_MMA(0, 1, At, B1); PG8_BAR; PG8_SCHED;
            PG8_LDA(At, 0, 1); PG8_STAGE(PG8_SB(0, 0), b2, voffB); PG8_STAGE(PG8_SB(0, 1), b2 + hstep, voffB); PG8_STAGE(PG8_SA(0, 0), a2, voffA);
            PG8_WAIT_V(8); PG8_WAIT_L(0); PG8_BAR; PG8_MMA(1, 0, At, B0); PG8_MMA(1, 1, At, B1); PG8_BAR; PG8_SCHED;
            PG8_LDB(B0, 1, 0); PG8_LDB(B1, 1, 1); PG8_SCHED; PG8_LDA(At, 1, 0); PG8_STAGE(PG8_SA(0, 1), a2 + hstep, voffA);
            PG8_WAIT_V(8); PG8_WAIT_L(0); PG8_BAR; PG8_MMA(0, 0, At, B0); PG8_MMA(0, 1, At, B1); PG8_BAR; PG8_SCHED;
            PG8_LDA(At, 1, 1); PG8_STAGE(PG8_SB(1, 0), b3, voffB); PG8_STAGE(PG8_SB(1, 1), b3 + hstep, voffB); PG8_STAGE(PG8_SA(1, 0), a3, voffA);
            PG8_WAIT_V(8); PG8_WAIT_L(0); PG8_BAR; PG8_MMA(1, 0, At, B0); PG8_MMA(1, 1, At, B1); PG8_BAR; PG8_SCHED;
            } else {
            PG8_LDB(B0, 0, 0); PG8_SCHED; PG8_LDA(At, 0, 0); PG8_STAGE(PG8_SA(1, 1), a1 + hstep, voffA);
            PG8_WAIT_L(8); PG8_BAR; PG8_WAIT_L(0); PG8_MMA(0, 0, At, B0); PG8_BAR; PG8_SCHED;
            PG8_LDB(B1, 0, 1); PG8_STAGE(PG8_SB(0, 0), b2, voffB);
            PG8_BAR; PG8_WAIT_L(0); PG8_MMA(0, 1, At, B1); PG8_BAR;
            PG8_LDA(At, 0, 1); PG8_STAGE(PG8_SA(0, 0), a2, voffA);
            PG8_BAR; PG8_WAIT_L(0); PG8_MMA(1, 0, At, B0); PG8_BAR; PG8_SCHED;
            PG8_STAGE(PG8_SB(0, 1), b2 + hstep, voffB);
            PG8_WAIT_V(6); PG8_BAR; PG8_MMA(1, 1, At, B1); PG8_BAR;
            PG8_LDB(B0, 1, 0); PG8_SCHED; PG8_LDA(At, 1, 0); PG8_STAGE(PG8_SA(0, 1), a2 + hstep, voffA);
            PG8_WAIT_L(8); PG8_BAR; PG8_WAIT_L(0); PG8_MMA(0, 0, At, B0); PG8_BAR; PG8_SCHED;
            PG8_LDB(B1, 1, 1); PG8_STAGE(PG8_SB(1, 0), b3, voffB);
            PG8_BAR; PG8_WAIT_L(0); PG8_MMA(0, 1, At, B1); PG8_BAR;
            PG8_LDA(At, 1, 1); PG8_STAGE(PG8_SA(1, 0), a3, voffA);
            PG8_BAR; PG8_WAIT_L(0); PG8_MMA(1, 0, At, B0); PG8_BAR; PG8_SCHED;
            PG8_STAGE(PG8_SB(1, 1), b3 + hstep, voffB);
            PG8_WAIT_V(6); PG8_BAR; PG8_MMA(1, 1, At, B1); PG8_BAR;
            }
        }
        if constexpr (ALIGN_EPI) { if (wr == 0) PG8_BAR; }
        if constexpr (!Epi::AFTER_DRAIN) { E(acc, cur, wr, wc, fr, fq); S.done(cur); }
        if (!has_next) break;
#pragma unroll
        for (int a = 0; a < 2; ++a)
#pragma unroll
            for (int b = 0; b < 2; ++b)
#pragma unroll
                for (int m = 0; m < 4; ++m)
#pragma unroll
                    for (int n = 0; n < 2; ++n) acc[a][b][m][n] = (f32x4){0.f, 0.f, 0.f, 0.f};
        cur = nxt; cA = nA; cB = nB; ++ui;
        if constexpr (ALIGN_EPI) { if (wr == 1) PG8_BAR; }
    }
    PG8_WAIT_V(0);
    if constexpr (!ALIGN_EPI) { if (wr == 0) PG8_BAR; }
    PG8_BAR;
    if constexpr (Epi::AFTER_DRAIN) { E.fused(acc, cur, wr, wc, fr, fq, lds, wid, lane); S.done(cur); }
#undef PG8_SA
#undef PG8_SB
#undef PG8_STAGE
#undef PG8_LDA
#undef PG8_LDB
#undef PG8_MMA
#undef PG8_WAIT_V
#undef PG8_WAIT_L
#undef PG8_BAR
#undef PG8_SCHED
}
}

#define LAS __attribute__((address_space(3)))
using pg8::bf16_t; using pg8::bf16x8; using pg8::f32x4; using pg8::u32x4;
typedef unsigned u32x2 __attribute__((ext_vector_type(2)));
typedef float f32x2 __attribute__((ext_vector_type(2)));
#define MFMA16(a, b, c) __builtin_amdgcn_mfma_f32_16x16x32_bf16((a), (b), (c), 0, 0, 0)

constexpr int ML = 16384, MC = 2048, MT = 18432, DM = 2048;
constexpr int LDS_BYTES = 155648;
constexpr int NPH = 21;
constexpr int P0LD = 4160;

constexpr size_t al256(size_t x) { return (x + 255) & ~(size_t)255; }
constexpr size_t WS_MOD   = 32768;
constexpr size_t WS_WABIN = al256(WS_MOD + (size_t)2 * 9 * 12288 * 4);
constexpr size_t WS_WABOUT = WS_WABIN + (size_t)4096 * 2048 * 2;
constexpr size_t WS_WGLU  = WS_WABOUT + (size_t)2048 * 2048 * 2;
constexpr size_t WS_W1    = WS_WGLU + (size_t)1024 * 1024 * 2;
constexpr size_t WS_W2    = WS_W1 + (size_t)2 * 8192 * 2048 * 2;
constexpr size_t WS_WGIN  = WS_W2 + (size_t)2 * 8192 * 2048 * 2;
constexpr size_t WS_WGOUT = WS_WGIN + (size_t)6400 * 2048 * 2;
constexpr size_t WS_XC    = WS_WGOUT + (size_t)2048 * 2048 * 2;
constexpr size_t WS_H     = WS_XC + (size_t)MC * DM * 4;
constexpr size_t WS_MIX   = WS_H + (size_t)MT * DM * 2;
constexpr size_t WS_BIG   = WS_MIX + (size_t)MT * DM * 2;
constexpr size_t WS_PROJ0 = WS_BIG;
constexpr size_t WS_VT0   = WS_PROJ0 + (size_t)MT * P0LD * 2;
constexpr size_t WS_YS5   = WS_VT0 + (size_t)8192 * 2304 * 2;
constexpr size_t WS_GL    = WS_YS5 + (size_t)2 * MT * 1024 * 2;
constexpr size_t WS_L0END = WS_GL + (size_t)MT * 1024 * 2;
constexpr size_t WS_HID   = WS_BIG;
constexpr size_t WS_HIDEND = WS_HID + (size_t)MT * 8192 * 2;
constexpr size_t WS_PART  = WS_HIDEND;
constexpr size_t WS_PARTEND = WS_PART + (size_t)4 * MC * DM * 4;
constexpr size_t WS_QK    = WS_BIG;
constexpr size_t WS_V1    = WS_QK + (size_t)MT * 2048 * 2;
constexpr size_t WS_G1    = WS_V1 + (size_t)MT * 2048 * 2;
constexpr size_t WS_A1    = WS_G1 + (size_t)MT * 2048 * 2;
constexpr size_t WS_QIN   = WS_A1 + (size_t)MT * 256 * 2;
constexpr size_t WS_KIN   = WS_QIN + (size_t)2 * MT * 1024 * 2;
constexpr size_t WS_DEC   = WS_KIN + (size_t)2 * MT * 1024 * 2;
constexpr size_t WS_L1END = WS_DEC + (size_t)2 * 288 * 4 * 256 * 4;
constexpr size_t WS_KENDT = WS_MIX;
constexpr size_t WS_VT1   = WS_H;
constexpr size_t cmax(size_t a, size_t b) { return a > b ? a : b; }
constexpr size_t WS_END   = cmax(cmax(WS_L0END, WS_PARTEND), WS_L1END);

struct Params { const float* in[29]; float* out; unsigned char* ws; int ph_lo, ph_hi; };

typedef __bf16 bf16v2_t __attribute__((ext_vector_type(2)));
__device__ __forceinline__ unsigned pk_bf16(float lo, float hi) { const f32x2 f = {lo, hi}; const bf16v2_t v = __builtin_convertvector(f, bf16v2_t); return __builtin_bit_cast(unsigned, v); }
__device__ __forceinline__ float bf_lo(unsigned u) { return __uint_as_float(u << 16); }
__device__ __forceinline__ float bf_hi(unsigned u) { return __uint_as_float(u & 0xffff0000u); }
__device__ __forceinline__ float bf1(bf16_t h) { return __uint_as_float((unsigned)h << 16); }
__device__ __forceinline__ float wave_sum(float v) {
#pragma unroll
    for (int o = 1; o < 64; o <<= 1) v += __shfl_xor(v, o);
    return v;
}
#define WAVE_LDS_SYNC() asm volatile("s_waitcnt lgkmcnt(0)" ::: "memory")

struct EpiBf16S {
    static constexpr bool PERM = true, AFTER_DRAIN = false;
    bf16_t *O0, *O1, *O2, *O3; int ld0, ld3; int split_cols; int act;
    __device__ __forceinline__ void operator()(const f32x4 (&acc)[2][2][4][2], const pg8::Unit& u, int wr, int wc, int fr, int fq) const {
        int colt = u.pn * 256; const int t = colt / split_cols; colt -= t * split_cols;
        bf16_t* base = t == 0 ? O0 : (t == 1 ? O1 : (t == 2 ? O2 : O3)); const int ld = t == 3 ? ld3 : ld0;
        const int row0 = u.pm * 256 + wr * 64 + fr, col0 = colt + wc * 32 + 8 * fq;
#pragma unroll
        for (int ai = 0; ai < 2; ++ai)
#pragma unroll
            for (int m = 0; m < 4; ++m) { bf16_t* rowp = base + (size_t)(row0 + ai * 128 + m * 16) * ld + col0;
#pragma unroll
                for (int bj = 0; bj < 2; ++bj) { f32x4 v0 = acc[ai][bj][m][0], v1 = acc[ai][bj][m][1];
                    if (act) {
#pragma unroll
                        for (int e = 0; e < 4; ++e) { float a = fmaxf(v0[e], 0.f), b = fmaxf(v1[e], 0.f); v0[e] = a * a; v1[e] = b * b; } }
                    u32x4 w; w.x = pk_bf16(v0[0], v0[1]); w.y = pk_bf16(v0[2], v0[3]); w.z = pk_bf16(v1[0], v1[1]); w.w = pk_bf16(v1[2], v1[3]);
                    *(u32x4*)(rowp + bj * 128) = w; } }
    }
};
struct EpiGlu {
    static constexpr bool PERM = true, AFTER_DRAIN = false;
    const bf16_t* GL; const float* bias; bf16_t* MIX;
    __device__ __forceinline__ void operator()(const f32x4 (&acc)[2][2][4][2], const pg8::Unit& u, int wr, int wc, int fr, int fq) const {
        const int row0 = u.pm * 256 + wr * 64 + fr, col0 = u.pn * 256 + wc * 32 + 8 * fq;
#pragma unroll
        for (int bj = 0; bj < 2; ++bj) { const int col = col0 + bj * 128;
            const f32x4 b0 = *(const f32x4*)(bias + col), b1 = *(const f32x4*)(bias + col + 4);
#pragma unroll
            for (int ai = 0; ai < 2; ++ai)
#pragma unroll
                for (int m = 0; m < 4; ++m) { const size_t row = (size_t)(row0 + ai * 128 + m * 16);
                    const u32x4 g = *(const u32x4*)(GL + row * 1024 + col);
                    const f32x4 v0 = acc[ai][bj][m][0] + b0, v1 = acc[ai][bj][m][1] + b1;
                    float gl[8] = {bf_lo(g.x), bf_hi(g.x), bf_lo(g.y), bf_hi(g.y), bf_lo(g.z), bf_hi(g.z), bf_lo(g.w), bf_hi(g.w)};
                    float o[8];
#pragma unroll
                    for (int e = 0; e < 4; ++e) { o[e] = gl[e] / (1.f + __expf(-v0[e])); o[4 + e] = gl[4 + e] / (1.f + __expf(-v1[e])); }
                    u32x4 w; w.x = pk_bf16(o[0], o[1]); w.y = pk_bf16(o[2], o[3]); w.z = pk_bf16(o[4], o[5]); w.w = pk_bf16(o[6], o[7]);
                    *(u32x4*)(MIX + row * 2048 + 1024 + col) = w; } }
    }
};
struct EpiResid {
    static constexpr bool PERM = true, AFTER_DRAIN = false;
    const float *inL, *inC; float *outL, *outC; const float* gate;
    __device__ __forceinline__ void operator()(const f32x4 (&acc)[2][2][4][2], const pg8::Unit& u, int wr, int wc, int fr, int fq) const {
        const int r0 = u.pm * 256; const bool lat = r0 < ML;
        const char* in = (const char*)(lat ? inL + (size_t)r0 * DM : inC + (size_t)(r0 - ML) * DM);
        char* out = (char*)(lat ? outL + (size_t)r0 * DM : outC + (size_t)(r0 - ML) * DM);
        const char* gp = (const char*)(gate + (size_t)(lat ? (r0 >> 11) : 8) * 12288);
        const unsigned colb = (unsigned)(u.pn * 256 + wc * 32 + 8 * fq) * 4u;
        const unsigned rowb = (unsigned)(wr * 64 + fr) * (unsigned)(DM * 4) + colb;
#pragma unroll
        for (int bj = 0; bj < 2; ++bj) {
            const f32x4 g0 = *(const f32x4*)(gp + colb + bj * 512), g1 = *(const f32x4*)(gp + colb + bj * 512 + 16);
#pragma unroll
            for (int ai = 0; ai < 2; ++ai)
#pragma unroll
                for (int m = 0; m < 4; ++m) { const unsigned off = rowb + (unsigned)((ai * 128 + m * 16) * DM * 4 + bj * 512);
                    const f32x4 x0 = *(const f32x4*)(in + off), x1 = *(const f32x4*)(in + off + 16);
                    *(f32x4*)(out + off) = x0 + g0 * acc[ai][bj][m][0];
                    *(f32x4*)(out + off + 16) = x1 + g1 * acc[ai][bj][m][1]; } }
    }
};

struct EpiPart {
    static constexpr bool PERM = true, AFTER_DRAIN = false;
    float* P;
    __device__ __forceinline__ void operator()(const f32x4 (&acc)[2][2][4][2], const pg8::Unit& u, int wr, int wc, int fr, int fq) const {
        char* out = (char*)(P + ((size_t)u.ks * MC + (size_t)(u.pm * 256 - ML)) * DM);
        const unsigned colb = (unsigned)(u.pn * 256 + wc * 32 + 8 * fq) * 4u;
        const unsigned rowb = (unsigned)(wr * 64 + fr) * (unsigned)(DM * 4) + colb;
#pragma unroll
        for (int bj = 0; bj < 2; ++bj)
#pragma unroll
            for (int ai = 0; ai < 2; ++ai)
#pragma unroll
                for (int m = 0; m < 4; ++m) { const unsigned off = rowb + (unsigned)((ai * 128 + m * 16) * DM * 4 + bj * 512);
                    *(f32x4*)(out + off) = acc[ai][bj][m][0]; *(f32x4*)(out + off + 16) = acc[ai][bj][m][1]; }
    }
};
struct SplitOrder {
    int G, c;
    __device__ bool next(int i, pg8::Unit& u) const { const long L = (long)i * G + c; if (L >= 256) return false; u.ks = (int)(L & 3); u.pn = (int)((L >> 2) & 7); u.pm = 64 + (int)(L >> 5); return true; }
    __device__ __forceinline__ void a_ready(const pg8::Unit&) const {}
    __device__ __forceinline__ void done(const pg8::Unit&) const {}
};

struct Proj1Order {
    pg8::StaticOrder S0; int G, c;
    __device__ void init(int G_, int c_) { S0.init(ML, 6400, G_, c_); G = G_; c = c_; }
    __device__ bool next(int i, pg8::Unit& u) const {
        const long L = (long)i * G + c;
        if (L < 1600) return S0.next(i, u);
        const int j = (int)(L - 1600); if (j >= 104) return false;
        const int jj = j % 13; u.pm = 64 + j / 13; u.pn = jj < 12 ? 4 + jj : 24; u.ks = 0; return true; }
    __device__ __forceinline__ void a_ready(const pg8::Unit&) const {}
    __device__ __forceinline__ void done(const pg8::Unit&) const {}
};

__device__ __forceinline__ void xpose_mat(const float* __restrict__ src, bf16_t* __restrict__ dst, int K, int N, int Npad, LAS unsigned* l32, int tid, int bid, int nblk) {
    const int nkt = K / 128, nnt = Npad / 64, tiles = nkt * nnt;
    const int n = tid & 63, kp0 = (tid >> 6) * 8;
    float cur[16], nxt[16];
    auto fetch = [&](int T, float (&v)[16]) { const int kt = T % nkt, ntile = T / nkt; const int k0 = kt * 128, n0 = ntile * 64; const bool ok = (n0 + n) < N;
        const float* sp = src + (size_t)(k0 + 2 * kp0) * N + n0 + n;
#pragma unroll
        for (int i = 0; i < 16; ++i) v[i] = ok ? sp[(size_t)i * N] : 0.f; };
    int T = bid;
    if (T < tiles) fetch(T, cur);
    for (; T < tiles; T += nblk) {
        const int kt = T % nkt, ntile = T / nkt; const int k0 = kt * 128, n0 = ntile * 64;
        const bool more = T + nblk < tiles;
        if (more) fetch(T + nblk, nxt);
#pragma unroll
        for (int i = 0; i < 8; ++i) l32[n * 65 + kp0 + i] = pk_bf16(cur[2 * i], cur[2 * i + 1]);
        __syncthreads();
#pragma unroll
        for (int q = 0; q < 2; ++q) {
            const int nn = q * 32 + (tid >> 4), j = tid & 15;
            u32x4 w; w.x = l32[nn * 65 + 4 * j]; w.y = l32[nn * 65 + 4 * j + 1]; w.z = l32[nn * 65 + 4 * j + 2]; w.w = l32[nn * 65 + 4 * j + 3];
            *(u32x4*)(dst + (size_t)(n0 + nn) * K + k0 + 8 * j) = w;
        }
        __syncthreads();
        if (more) {
#pragma unroll
            for (int i = 0; i < 16; ++i) cur[i] = nxt[i]; }
    }
}

__device__ __forceinline__ void phase_prep(const Params& p, LAS unsigned char* lds, int tid, int bid, int nblk) {
    const int wid = tid >> 6, lane = tid & 63;
    LAS float* sl = (LAS float*)lds;
    LAS float* red = sl + 9 * 2048;
    for (int i = tid; i < 9 * 2048; i += 512) { const float v = i < 8 * 2048 ? p.in[1][i] : p.in[3][i - 8 * 2048]; sl[i] = v / (1.f + expf(-v)); }
    __syncthreads();
    float* mod = (float*)(p.ws + WS_MOD);
    const int c4 = (lane & 15) * 4, ksub = lane >> 4;
    for (int item = bid; item < 384; item += nblk) {
        const int l = item / 192, cc = (item % 192) * 64;
        const float* W = p.in[4] + (size_t)l * 2048 * 12288 + cc + c4;
        f32x4 acc[9];
#pragma unroll
        for (int r = 0; r < 9; ++r) acc[r] = (f32x4){0.f, 0.f, 0.f, 0.f};
        const int k0 = wid * 256 + ksub;
        for (int kk = 0; kk < 256; kk += 32) {
            f32x4 w[8];
#pragma unroll
            for (int u = 0; u < 8; ++u) w[u] = *(const f32x4*)(W + (size_t)(k0 + kk + 4 * u) * 12288);
#pragma unroll
            for (int u = 0; u < 8; ++u)
#pragma unroll
                for (int r = 0; r < 9; ++r) acc[r] += w[u] * sl[r * 2048 + k0 + kk + 4 * u];
        }
#pragma unroll
        for (int r = 0; r < 9; ++r) {
#pragma unroll
            for (int e = 0; e < 4; ++e) { float v = acc[r][e]; v += __shfl_xor(v, 16); v += __shfl_xor(v, 32); acc[r][e] = v; }
            if (ksub == 0) *(LAS f32x4*)(red + (wid * 9 + r) * 64 + c4) = acc[r]; }
        __syncthreads();
        for (int o = tid; o < 576; o += 512) { const int r = o >> 6, c = o & 63; float s_ = 0.f;
#pragma unroll
            for (int w = 0; w < 8; ++w) s_ += red[(w * 9 + r) * 64 + c];
            mod[(size_t)(l * 9 + r) * 12288 + cc + c] = s_ + p.in[5][l * 12288 + cc + c]; }
        __syncthreads();
    }
    LAS unsigned* l32 = (LAS unsigned*)lds;
    __syncthreads();
    if ((nblk & 1) == 0 && nblk >= 2) { if (bid >= nblk / 2) xpose_mat(p.in[11], (bf16_t*)(p.ws + WS_WABIN), 2048, 4096, 4096, l32, tid, bid - nblk / 2, nblk / 2); }
    else xpose_mat(p.in[11], (bf16_t*)(p.ws + WS_WABIN), 2048, 4096, 4096, l32, tid, bid, nblk);
}

__device__ __forceinline__ void phase_norm(const float* XL, const float* XC, const float* gvec, const float* modl, int sh_off, int sc_off, bf16_t* H, int nrows, int gw, int nw, int lane, const float* PART = nullptr, const float* pgate = nullptr) {
    auto xrow = [&](int r_) { return r_ < ML ? XL + (size_t)r_ * DM : XC + (size_t)(r_ - ML) * DM; };
    f32x4 v[8], vn[8];
    if (gw < nrows) { const float* x0 = xrow(gw);
#pragma unroll
        for (int i = 0; i < 8; ++i) v[i] = *(const f32x4*)(x0 + i * 256 + lane * 4); }
    for (int row = gw; row < nrows; row += nw) {
        const float* mr = modl + (size_t)(row < ML ? (row >> 11) : 8) * 12288;
        if (row + nw < nrows) { const float* xn = xrow(row + nw);
#pragma unroll
            for (int i = 0; i < 8; ++i) vn[i] = *(const f32x4*)(xn + i * 256 + lane * 4); }
        float ss = 0.f;
#pragma unroll
        for (int i = 0; i < 8; ++i) {
            if (PART && row >= ML) { const float* pp = PART + (size_t)(row - ML) * DM + i * 256 + lane * 4;
                const f32x4 ps = (*(const f32x4*)pp + *(const f32x4*)(pp + (size_t)MC * DM)) + (*(const f32x4*)(pp + (size_t)2 * MC * DM) + *(const f32x4*)(pp + (size_t)3 * MC * DM));
                v[i] = v[i] + *(const f32x4*)(pgate + i * 256 + lane * 4) * ps; }
            ss += v[i][0] * v[i][0] + v[i][1] * v[i][1] + v[i][2] * v[i][2] + v[i][3] * v[i][3]; }
        ss = wave_sum(ss);
        const float rstd = rsqrtf(ss * (1.f / 2048.f) + 1e-6f);
#pragma unroll
        for (int i = 0; i < 8; ++i) { const int col = i * 256 + lane * 4;
            const f32x4 g = *(const f32x4*)(gvec + col), sc = *(const f32x4*)(mr + sc_off + col), sh = *(const f32x4*)(mr + sh_off + col);
            const f32x4 y = v[i] * rstd * g * (sc + 1.f) + sh;
            u32x2 w; w.x = pk_bf16(y[0], y[1]); w.y = pk_bf16(y[2], y[3]);
            *(u32x2*)(H + (size_t)row * DM + col) = w; }
#pragma unroll
        for (int i = 0; i < 8; ++i) v[i] = vn[i];
    }
}
__device__ __forceinline__ void phase_final_norm(float* X, const float* gvec, int gw, int nw, int lane) {
    for (int row = gw; row < ML; row += nw) {
        float* x = X + (size_t)row * DM;
        f32x4 v[8]; float ss = 0.f;
#pragma unroll
        for (int i = 0; i < 8; ++i) { v[i] = *(const f32x4*)(x + i * 256 + lane * 4); ss += v[i][0] * v[i][0] + v[i][1] * v[i][1] + v[i][2] * v[i][2] + v[i][3] * v[i][3]; }
        ss = wave_sum(ss);
        const float rstd = rsqrtf(ss * (1.f / 2048.f) + 1e-6f);
#pragma unroll
        for (int i = 0; i < 8; ++i) { const int col = i * 256 + lane * 4; const f32x4 g = *(const f32x4*)(gvec + col); *(f32x4*)(x + col) = v[i] * rstd * g; }
    }
}

__device__ __forceinline__ void phase_vt0(const Params& p, int tid, int bid, int nblk) {
    const bf16_t* P0 = (const bf16_t*)(p.ws + WS_PROJ0); bf16_t* VT = (bf16_t*)(p.ws + WS_VT0);
    for (int item = bid; item < 576; item += nblk) {
        const int cid = item >> 1, vc = (item & 1) * 512 + tid;
        int b, pos0;
        if (cid < 256) { b = cid >> 5; pos0 = 256 + (cid & 31) * 64; } else { const int cc = cid - 256; b = cc >> 2; pos0 = (cc & 3) * 64; }
        const bf16_t* src = P0 + (size_t)cid * 64 * P0LD + 2048 + vc;
        bf16_t* dst = VT + (((size_t)(b * 8 + (vc >> 7)) * 288 + (pos0 >> 3)) * 128 + (vc & 127)) * 8;
#pragma unroll
        for (int q = 0; q < 8; ++q) { unsigned w[4];
#pragma unroll
            for (int e = 0; e < 4; ++e) { const unsigned lo = src[(size_t)(q * 8 + 2 * e) * P0LD], hi = src[(size_t)(q * 8 + 2 * e + 1) * P0LD]; w[e] = lo | (hi << 16); }
            u32x4 o; o.x = w[0]; o.y = w[1]; o.z = w[2]; o.w = w[3];
            *(u32x4*)(dst + (size_t)q * 1024) = o; }
    }
}

__device__ __forceinline__ void s5_disc(float lr, float li, float dt, float& ar, float& ai, float& f_r, float& f_i) {
    const float mag = expf(lr * dt); float sn, cs; sincosf(li * dt, &sn, &cs);
    ar = mag * cs; ai = mag * sn; const float den = lr * lr + li * li;
    f_r = ((ar - 1.f) * lr + ai * li) / den; f_i = (ai * lr - (ar - 1.f) * li) / den;
}
__device__ __forceinline__ void s5_wave(const Params& p, int sw, LAS unsigned char* wl, int lane) {
    const int b = sw >> 7, g = (sw >> 1) & 63, dir = sw & 1;
    const int fr = lane & 15, fq = lane >> 4;
    const int pg = dir * 64 + g;
    const float* LR = p.in[14] + pg * 64; const float* LI = p.in[15] + pg * 64;
    const float dt = expf(p.in[16][pg]);
    const float* BR = p.in[17] + (size_t)pg * 1024; const float* BI = p.in[18] + (size_t)pg * 1024;
    const float* CR = p.in[19] + (size_t)pg * 1024; const float* CI = p.in[20] + (size_t)pg * 1024;
    float ar, ai; { float t0, t1; s5_disc(LR[lane], LI[lane], dt, ar, ai, t0, t1); }
    bf16x8 bbA[8];
#pragma unroll
    for (int q = 0; q < 8; ++q) {
        const int sg = q * 16 + fr, pp = sg >> 1, part = sg & 1;
        float a_r, a_i, f_r, f_i; s5_disc(LR[pp], LI[pp], dt, a_r, a_i, f_r, f_i);
        u32x4 w = {0u, 0u, 0u, 0u};
        if (fq < 2) {
            const f32x4 br0 = *(const f32x4*)(BR + pp * 16 + fq * 8), br1 = *(const f32x4*)(BR + pp * 16 + fq * 8 + 4);
            const f32x4 bi0 = *(const f32x4*)(BI + pp * 16 + fq * 8), bi1 = *(const f32x4*)(BI + pp * 16 + fq * 8 + 4);
            f32x4 v0, v1;
            if (part == 0) { v0 = br0 * f_r - bi0 * f_i; v1 = br1 * f_r - bi1 * f_i; } else { v0 = bi0 * f_r + br0 * f_i; v1 = bi1 * f_r + br1 * f_i; }
            w.x = pk_bf16(v0[0], v0[1]); w.y = pk_bf16(v0[2], v0[3]); w.z = pk_bf16(v1[0], v1[1]); w.w = pk_bf16(v1[2], v1[3]);
        }
        bbA[q] = __builtin_bit_cast(bf16x8, w);
    }
    bf16x8 cA[4];
#pragma unroll
    for (int kk = 0; kk < 4; ++kk) { const int p0 = kk * 16 + fq * 4;
        const f32x4 cr = *(const f32x4*)(CR + fr * 64 + p0), ci = *(const f32x4*)(CI + fr * 64 + p0);
        u32x4 w; w.x = pk_bf16(cr[0], -ci[0]); w.y = pk_bf16(cr[1], -ci[1]); w.z = pk_bf16(cr[2], -ci[2]); w.w = pk_bf16(cr[3], -ci[3]);
        cA[kk] = __builtin_bit_cast(bf16x8, w); }
    LAS float* BU = (LAS float*)wl;
    LAS unsigned* HH = (LAS unsigned*)(wl + 16 * 132 * 4);
    const bf16_t* P0 = (const bf16_t*)(p.ws + WS_PROJ0);
    bf16_t* YS = (bf16_t*)(p.ws + WS_YS5) + (size_t)dir * MT * 1024;
    float hr = 0.f, hi = 0.f;
    const f32x4 z4 = {0.f, 0.f, 0.f, 0.f};
    auto rowof = [&](int ti_) { const int s = ti_ * 16 + fr;
        return dir == 0 ? (s < 256 ? ML + b * 256 + s : b * 2048 + (s - 256)) : (s < 256 ? ML + b * 256 + 255 - s : b * 2048 + 2047 - (s - 256)); };
    int row_n = rowof(0);
    u32x4 uw_n = {0u, 0u, 0u, 0u};
    if (fq < 2) uw_n = *(const u32x4*)(P0 + (size_t)row_n * P0LD + 3072 + g * 16 + fq * 8);
    for (int ti = 0; ti < 144; ++ti) {
        const int row = row_n; const bf16x8 ub = __builtin_bit_cast(bf16x8, uw_n);
        if (ti + 1 < 144) { row_n = rowof(ti + 1); if (fq < 2) uw_n = *(const u32x4*)(P0 + (size_t)row_n * P0LD + 3072 + g * 16 + fq * 8); }
#pragma unroll
        for (int q = 0; q < 8; ++q) { const f32x4 d = MFMA16(bbA[q], ub, z4); *(LAS f32x4*)(BU + fr * 132 + q * 16 + fq * 4) = d; }
        WAVE_LDS_SYNC();
        f32x2 bu[16];
#pragma unroll
        for (int t = 0; t < 16; ++t) bu[t] = *(const LAS f32x2*)(BU + t * 132 + 2 * lane);
#pragma unroll
        for (int t = 0; t < 16; ++t) {
            const float nr = ar * hr - ai * hi + bu[t].x, ni = ar * hi + ai * hr + bu[t].y; hr = nr; hi = ni;
            HH[t * 68 + lane] = pk_bf16(hr, hi); }
        WAVE_LDS_SYNC();
        f32x4 y = z4;
#pragma unroll
        for (int kk = 0; kk < 4; ++kk) { const bf16x8 hb = *(const LAS bf16x8*)(HH + fr * 68 + kk * 16 + fq * 4); y = MFMA16(cA[kk], hb, y); }
        u32x2 o; o.x = pk_bf16(y[0], y[1]); o.y = pk_bf16(y[2], y[3]);
        *(u32x2*)(YS + (size_t)row * 1024 + g * 16 + fq * 4) = o;
        WAVE_LDS_SYNC();
    }
}

__device__ __forceinline__ void na_item(const Params& p, int item, int lane, const LAS float* RBL) {
    const bf16_t* P0 = (const bf16_t*)(p.ws + WS_PROJ0); const bf16_t* VT = (const bf16_t*)(p.ws + WS_VT0); bf16_t* MIX = (bf16_t*)(p.ws + WS_MIX);
    const int fr = lane & 15, fq = lane >> 4;
    int b, h, c0 = 0, ks0 = 0, nwin = 0, rsA = 0, rsB = 0, rA = 0, rB = 0, qrowA, qrowB;
    if (item < 4096) { b = item >> 9; const int rem = item & 511; h = rem >> 6; const int pr = rem & 63; rA = (pr >> 2) * 2; rB = rA + 1; c0 = (pr & 3) * 16;
        rsA = min(max(rA - 4, 0), 24); rsB = min(max(rB - 4, 0), 24); nwin = rsB - rsA + 8; ks0 = min(max(c0 - 8, 0), 32);
        qrowA = b * 2048 + rA * 64 + c0 + fr; qrowB = qrowA + 64; }
    else { const int it = item - 4096; b = it >> 6; h = (it >> 3) & 7; qrowA = ML + b * 256 + (it & 7) * 32 + fr; qrowB = qrowA + 16; }
    const int nblkk = 8 + nwin;
    bf16x8 qfA[4], qfB[4];
#pragma unroll
    for (int kk = 0; kk < 4; ++kk) { qfA[kk] = *(const bf16x8*)(P0 + (size_t)qrowA * P0LD + h * 128 + kk * 32 + fq * 8); qfB[kk] = *(const bf16x8*)(P0 + (size_t)qrowB * P0LD + h * 128 + kk * 32 + fq * 8); }
    float mA = -1e30f, lA = 0.f, mB = -1e30f, lB = 0.f;
    f32x4 oA[8], oB[8];
    const f32x4 z4 = {0.f, 0.f, 0.f, 0.f};
#pragma unroll
    for (int dt = 0; dt < 8; ++dt) { oA[dt] = z4; oB[dt] = z4; }
    const int qcol = c0 + fr, wst = min(max(qcol - 8, 0), 48);
    auto krow_of = [&](int blk_) { return blk_ < 8 ? ML + b * 256 + blk_ * 32 : b * 2048 + (rsA + blk_ - 8) * 64 + ks0; };
    const int kperm = (fr >> 2) * 8 + (fr & 3);
    bf16x8 kc0[4], kc1[4];
    { const bf16_t* kp0 = P0 + (size_t)(krow_of(0) + kperm) * P0LD + 1024 + h * 128 + fq * 8;
#pragma unroll
      for (int kk = 0; kk < 4; ++kk) { kc0[kk] = *(const bf16x8*)(kp0 + kk * 32); kc1[kk] = *(const bf16x8*)(kp0 + (size_t)4 * P0LD + kk * 32); } }
    for (int blk = 0; blk < nblkk; ++blk) {
        const int wrow = rsA + blk - 8;
        const int vpos0 = blk < 8 ? blk * 32 : 256 + wrow * 64 + ks0;
        const bf16_t* vp = VT + (((size_t)(b * 8 + h) * 288 + (vpos0 >> 3) + fq) * 128 + fr) * 8;
        u32x4 vv[8];
#pragma unroll
        for (int dt = 0; dt < 8; ++dt) vv[dt] = *(const u32x4*)(vp + dt * 128);
        bf16x8 kn0[4], kn1[4];
        { const int nb = blk + 1 < nblkk ? blk + 1 : blk; const bf16_t* kp0 = P0 + (size_t)(krow_of(nb) + kperm) * P0LD + 1024 + h * 128 + fq * 8;
#pragma unroll
          for (int kk = 0; kk < 4; ++kk) { kn0[kk] = *(const bf16x8*)(kp0 + kk * 32); kn1[kk] = *(const bf16x8*)(kp0 + (size_t)4 * P0LD + kk * 32); } }
        f32x4 a0 = z4, a1 = z4, b0 = z4, b1 = z4;
#pragma unroll
        for (int kk = 0; kk < 4; ++kk) { a0 = MFMA16(kc0[kk], qfA[kk], a0); a1 = MFMA16(kc1[kk], qfA[kk], a1); b0 = MFMA16(kc0[kk], qfB[kk], b0); b1 = MFMA16(kc1[kk], qfB[kk], b1); }
        float sA[8], sB[8];
#pragma unroll
        for (int jj = 0; jj < 4; ++jj) { sA[jj] = a0[jj] * 0.08838834764831845f; sA[4 + jj] = a1[jj] * 0.08838834764831845f; sB[jj] = b0[jj] * 0.08838834764831845f; sB[4 + jj] = b1[jj] * 0.08838834764831845f; }
        if (blk >= 8) {
            const bool actA = wrow >= rsA && wrow < rsA + 8, actB = wrow >= rsB && wrow < rsB + 8;
            const int riA = min(max(wrow - rA + 7, 0), 14), riB = min(max(wrow - rB + 7, 0), 14);
            const LAS float* rbA = RBL + (h * 15 + riA) * 31; const LAS float* rbB = RBL + (h * 15 + riB) * 31;
            float bvA[8], bvB[8];
#pragma unroll
            for (int e = 0; e < 8; ++e) { const int ci = min(max(ks0 + fq * 8 + e - qcol + 15, 0), 30); bvA[e] = rbA[ci]; bvB[e] = rbB[ci]; }
#pragma unroll
            for (int e = 0; e < 8; ++e) { const int kcol = ks0 + fq * 8 + e; const bool ok = kcol >= wst && kcol < wst + 16;
                sA[e] = (ok && actA) ? sA[e] + bvA[e] : -1e30f; sB[e] = (ok && actB) ? sB[e] + bvB[e] : -1e30f; } }
        float bmA = sA[0], bmB = sB[0];
#pragma unroll
        for (int e = 1; e < 8; ++e) { bmA = fmaxf(bmA, sA[e]); bmB = fmaxf(bmB, sB[e]); }
        bmA = fmaxf(bmA, __shfl_xor(bmA, 16)); bmA = fmaxf(bmA, __shfl_xor(bmA, 32)); bmB = fmaxf(bmB, __shfl_xor(bmB, 16)); bmB = fmaxf(bmB, __shfl_xor(bmB, 32));
        const float mnA = fmaxf(mA, bmA), alA = __expf(mA - mnA), mnB = fmaxf(mB, bmB), alB = __expf(mB - mnB);
        float psA = 0.f, psB = 0.f;
#pragma unroll
        for (int e = 0; e < 8; ++e) { sA[e] = __expf(sA[e] - mnA); psA += sA[e]; sB[e] = __expf(sB[e] - mnB); psB += sB[e]; }
        psA += __shfl_xor(psA, 16); psA += __shfl_xor(psA, 32); psB += __shfl_xor(psB, 16); psB += __shfl_xor(psB, 32);
        lA = lA * alA + psA; mA = mnA; lB = lB * alB + psB; mB = mnB;
        u32x4 pwA, pwB;
        pwA.x = pk_bf16(sA[0], sA[1]); pwA.y = pk_bf16(sA[2], sA[3]); pwA.z = pk_bf16(sA[4], sA[5]); pwA.w = pk_bf16(sA[6], sA[7]);
        pwB.x = pk_bf16(sB[0], sB[1]); pwB.y = pk_bf16(sB[2], sB[3]); pwB.z = pk_bf16(sB[4], sB[5]); pwB.w = pk_bf16(sB[6], sB[7]);
        const bf16x8 pfA = __builtin_bit_cast(bf16x8, pwA), pfB = __builtin_bit_cast(bf16x8, pwB);
#pragma unroll
        for (int dt = 0; dt < 8; ++dt) { const bf16x8 vf = __builtin_bit_cast(bf16x8, vv[dt]);
            oA[dt] = oA[dt] * alA; oA[dt] = MFMA16(vf, pfA, oA[dt]); oB[dt] = oB[dt] * alB; oB[dt] = MFMA16(vf, pfB, oB[dt]); }
#pragma unroll
        for (int kk = 0; kk < 4; ++kk) { kc0[kk] = kn0[kk]; kc1[kk] = kn1[kk]; }
    }
    const float invA = 1.f / lA, invB = 1.f / lB;
    bf16_t* opA = MIX + (size_t)qrowA * 2048 + h * 128 + fq * 4; bf16_t* opB = MIX + (size_t)qrowB * 2048 + h * 128 + fq * 4;
#pragma unroll
    for (int dt = 0; dt < 8; ++dt) { u32x2 o; o.x = pk_bf16(oA[dt][0] * invA, oA[dt][1] * invA); o.y = pk_bf16(oA[dt][2] * invA, oA[dt][3] * invA); *(u32x2*)(opA + dt * 16) = o;
        u32x2 o2; o2.x = pk_bf16(oB[dt][0] * invB, oB[dt][1] * invB); o2.y = pk_bf16(oB[dt][2] * invB, oB[dt][3] * invB); *(u32x2*)(opB + dt * 16) = o2; }
}

__device__ __forceinline__ void xpose_wave_tile(const float* __restrict__ src, bf16_t* __restrict__ dst, int K, int N, int kt, int ntile, LAS unsigned* l32, int lane) {
    const int k0 = kt * 64, n0 = ntile * 64; const bool ok = (n0 + lane) < N;
    const float* sp = src + (size_t)k0 * N + n0 + lane;
#pragma unroll
    for (int hh = 0; hh < 2; ++hh) { float v[32];
#pragma unroll
        for (int i = 0; i < 32; ++i) v[i] = ok ? sp[(size_t)(hh * 32 + i) * N] : 0.f;
#pragma unroll
        for (int i = 0; i < 16; ++i) l32[lane * 33 + hh * 16 + i] = pk_bf16(v[2 * i], v[2 * i + 1]); }
    WAVE_LDS_SYNC();
#pragma unroll
    for (int j = 0; j < 8; ++j) { const int c = j * 64 + lane, row = c >> 3, chn = c & 7;
        u32x4 w; w.x = l32[row * 33 + chn * 4]; w.y = l32[row * 33 + chn * 4 + 1]; w.z = l32[row * 33 + chn * 4 + 2]; w.w = l32[row * 33 + chn * 4 + 3];
        *(u32x4*)(dst + (size_t)(n0 + row) * K + k0 + chn * 8) = w; }
    WAVE_LDS_SYNC();
}
__device__ __forceinline__ void xpose_item(const Params& p, int tile, LAS unsigned* l32, int lane) {
    const float* src; bf16_t* dst; int K, N, nkt;
    if (tile < 1024) { src = p.in[12]; dst = (bf16_t*)(p.ws + WS_WABOUT); K = 2048; N = 2048; nkt = 32; }
    else if (tile < 1280) { tile -= 1024; src = p.in[22]; dst = (bf16_t*)(p.ws + WS_WGLU); K = 1024; N = 1024; nkt = 16; }
    else if (tile < 5376) { tile -= 1280; src = p.in[8]; dst = (bf16_t*)(p.ws + WS_W1); K = 2048; N = 8192; nkt = 32; }
    else if (tile < 9472) { tile -= 5376; src = p.in[8] + (size_t)2048 * 8192; dst = (bf16_t*)(p.ws + WS_W1) + (size_t)8192 * 2048; K = 2048; N = 8192; nkt = 32; }
    else if (tile < 13568) { tile -= 9472; src = p.in[9]; dst = (bf16_t*)(p.ws + WS_W2); K = 8192; N = 2048; nkt = 128; }
    else if (tile < 17664) { tile -= 13568; src = p.in[9] + (size_t)8192 * 2048; dst = (bf16_t*)(p.ws + WS_W2) + (size_t)2048 * 8192; K = 8192; N = 2048; nkt = 128; }
    else if (tile < 20864) { tile -= 17664; src = p.in[24]; dst = (bf16_t*)(p.ws + WS_WGIN); K = 2048; N = 6176; nkt = 32; }
    else { tile -= 20864; src = p.in[28]; dst = (bf16_t*)(p.ws + WS_WGOUT); K = 2048; N = 2048; nkt = 32; }
    xpose_wave_tile(src, dst, K, N, tile % nkt, tile / nkt, l32, lane);
}

__device__ __forceinline__ void phase_mix0(const Params& p, LAS unsigned char* lds, int tid, int bid, int nblk) {
    const int wid = tid >> 6, lane = tid & 63;
    LAS float* RBL = (LAS float*)(lds + 51200);
    LAS unsigned* XL32 = (LAS unsigned*)(lds + 66560 + wid * 8448);
    for (int i = tid; i < 8 * 15 * 31; i += 512) RBL[i] = p.in[13][i];
    __syncthreads();
    if (wid < 4) { for (int sw = bid * 4 + wid; sw < 1024; sw += nblk * 4) s5_wave(p, sw, lds + wid * 12800, lane); }
    unsigned* ctr = (unsigned*)p.ws + 16;
    for (;;) { unsigned it = 0; if (lane == 0) it = atomicAdd(ctr, 1u); it = __builtin_amdgcn_readfirstlane(it); if (it >= 4608u + 2736u) break;
        if (it < 5472u) { if (it & 1u) { const int t0 = (int)(it >> 1) * 8; for (int j = 0; j < 8; ++j) xpose_item(p, t0 + j, XL32, lane); } else na_item(p, (int)(it >> 1), lane, RBL); }
        else na_item(p, (int)(it - 2736u), lane, RBL); }
}

__device__ __forceinline__ void phase_s5fin(const Params& p, int gt, int nt) {
    const bf16_t* P0 = (const bf16_t*)(p.ws + WS_PROJ0); const bf16_t* YF = (const bf16_t*)(p.ws + WS_YS5); const bf16_t* YB = YF + (size_t)MT * 1024;
    bf16_t* GL = (bf16_t*)(p.ws + WS_GL); const float* Dk = p.in[21];
    for (int i = gt; i < MT * 128; i += nt) { const int row = i >> 7, c8 = (i & 127) * 8;
        const u32x4 u = *(const u32x4*)(P0 + (size_t)row * P0LD + 3072 + c8), yf = *(const u32x4*)(YF + (size_t)row * 1024 + c8), yb = *(const u32x4*)(YB + (size_t)row * 1024 + c8);
        const f32x4 d0 = *(const f32x4*)(Dk + c8), d1 = *(const f32x4*)(Dk + c8 + 4);
        float v[8] = {bf_lo(yf.x) + bf_lo(yb.x) + d0[0] * bf_lo(u.x), bf_hi(yf.x) + bf_hi(yb.x) + d0[1] * bf_hi(u.x), bf_lo(yf.y) + bf_lo(yb.y) + d0[2] * bf_lo(u.y), bf_hi(yf.y) + bf_hi(yb.y) + d0[3] * bf_hi(u.y),
                      bf_lo(yf.z) + bf_lo(yb.z) + d1[0] * bf_lo(u.z), bf_hi(yf.z) + bf_hi(yb.z) + d1[1] * bf_hi(u.z), bf_lo(yf.w) + bf_lo(yb.w) + d1[2] * bf_lo(u.w), bf_hi(yf.w) + bf_hi(yb.w) + d1[3] * bf_hi(u.w)};
#pragma unroll
        for (int e = 0; e < 8; ++e) { const float x = v[e], t = __builtin_amdgcn_rcpf(fabsf(x) * 0.2316418882f + 1.0f);
            float q = t * 0.5307027145f + (-0.7265760135f); q = q * t + 0.7107068705f; q = q * t + (-0.142248368f); q = q * t + 0.127414796f; q = q * t;
            const float m = x * (q * __builtin_amdgcn_exp2f((x * x) * (-0.72134752044f))); v[e] = x < 0.f ? m : x - m; }
        u32x4 w; w.x = pk_bf16(v[0], v[1]); w.y = pk_bf16(v[2], v[3]); w.z = pk_bf16(v[4], v[5]); w.w = pk_bf16(v[6], v[7]);
        *(u32x4*)(GL + (size_t)row * 1024 + c8) = w; }
}

__device__ __forceinline__ void phase_glaprep(const Params& p, LAS unsigned char* lds, int tid, int bid, int nblk) {
    const bf16_t* QK = (const bf16_t*)(p.ws + WS_QK); const bf16_t* V1 = (const bf16_t*)(p.ws + WS_V1); const bf16_t* A1 = (const bf16_t*)(p.ws + WS_A1);
    bf16_t* QIN = (bf16_t*)(p.ws + WS_QIN); bf16_t* KIN = (bf16_t*)(p.ws + WS_KIN); bf16_t* KENDT = (bf16_t*)(p.ws + WS_KENDT); bf16_t* VT1 = (bf16_t*)(p.ws + WS_VT1);
    float* DEC = (float*)(p.ws + WS_DEC);
    LAS float* AC = (LAS float*)lds;
    LAS bf16_t* KE = (LAS bf16_t*)(lds + 8192);
    LAS bf16_t* QL = (LAS bf16_t*)(lds + 8192 + 67584);
    LAS bf16_t* KL = QL + 64 * 264;
    LAS float* HS = (LAS float*)(lds + 143360);
    for (int item = bid; item < 1152; item += nblk) {
        const int cid = item >> 2, h = item & 3; const int row0 = cid * 64; const bool lat = cid < 256;
        __syncthreads();
        { const int t = tid >> 3, c4 = (tid & 7) * 4; const u32x2 a = *(const u32x2*)(A1 + (size_t)(row0 + t) * 256 + c4);
          AC[t * 32 + c4] = bf_lo(a.x); AC[t * 32 + c4 + 1] = bf_hi(a.x); AC[t * 32 + c4 + 2] = bf_lo(a.y); AC[t * 32 + c4 + 3] = bf_hi(a.y); }
#pragma unroll
        for (int i = 0; i < 4; ++i) { const int piece = tid + i * 512, r = piece >> 5, c16 = piece & 31;
            const bf16_t* src = QK + (size_t)(row0 + r) * 2048 + h * 256 + c16 * 8;
            *(LAS u32x4*)(QL + r * 264 + c16 * 8) = *(const u32x4*)src;
            *(LAS u32x4*)(KL + r * 264 + c16 * 8) = *(const u32x4*)(src + 1024); }
        { const bf16_t* src = V1 + (size_t)row0 * 2048 + h * 512 + tid; LAS unsigned* vrow = (LAS unsigned*)(KE + tid * 66);
#pragma unroll
          for (int q = 0; q < 8; ++q) {
#pragma unroll
              for (int e = 0; e < 4; ++e) { const unsigned lo = src[(size_t)(q * 8 + 2 * e) * 2048], hi = src[(size_t)(q * 8 + 2 * e + 1) * 2048]; vrow[q * 4 + e] = lo | (hi << 16); } } }
        __syncthreads();
        { const int wv_ = tid >> 6, ln_ = tid & 63; bf16_t* dstb = VT1 + (size_t)(cid * 4 + h) * 512 * 64;
#pragma unroll
          for (int j = 0; j < 8; ++j) { const int row = wv_ * 64 + j * 8 + (ln_ >> 3), chn = ln_ & 7; const LAS unsigned* kr = (const LAS unsigned*)(KE + row * 66) + chn * 4;
              u32x4 o; o.x = kr[0]; o.y = kr[1]; o.z = kr[2]; o.w = kr[3]; *(u32x4*)(dstb + (size_t)row * 64 + chn * 8) = o; } }
        __syncthreads();
        const int dir = tid >> 8, th = (tid >> 7) & 1, dk0 = (tid & 127) * 2, ch = h * 256 + dk0, t0 = th * 32;
        float wa[16], wb[16];
#pragma unroll
        for (int r = 0; r < 16; ++r) { const f32x2 w2 = *(const f32x2*)(p.in[25] + (size_t)(dir * 16 + r) * 1024 + ch); wa[r] = w2.x; wb[r] = w2.y; }
        const f32x2 ba2 = *(const f32x2*)(p.in[26] + dir * 1024 + ch);
        LAS bf16_t* kela = KE + (dir * 256 + dk0) * 66 + t0;
        LAS bf16_t* kelb = kela + 66;
        float hs0 = 0.f, hs1 = 0.f;
#pragma unroll 4
        for (int tt = 0; tt < 32; ++tt) { const int t = t0 + tt; float z0 = ba2.x, z1 = ba2.y;
#pragma unroll
            for (int r4 = 0; r4 < 4; ++r4) { const f32x4 a = *(const LAS f32x4*)(AC + t * 32 + dir * 16 + r4 * 4);
                z0 += a[0] * wa[r4 * 4] + a[1] * wa[r4 * 4 + 1] + a[2] * wa[r4 * 4 + 2] + a[3] * wa[r4 * 4 + 3];
                z1 += a[0] * wb[r4 * 4] + a[1] * wb[r4 * 4 + 1] + a[2] * wb[r4 * 4 + 2] + a[3] * wb[r4 * 4 + 3]; }
            const _Float16 l0 = (_Float16)((fminf(z0, 0.f) - __logf(1.f + __expf(-fabsf(z0)))) * (1.f / 16.f));
            const _Float16 l1 = (_Float16)((fminf(z1, 0.f) - __logf(1.f + __expf(-fabsf(z1)))) * (1.f / 16.f));
            kela[tt] = __builtin_bit_cast(unsigned short, l0); kelb[tt] = __builtin_bit_cast(unsigned short, l1); hs0 += (float)l0; hs1 += (float)l1; }
        HS[tid * 2] = hs0; HS[tid * 2 + 1] = hs1;
        __syncthreads();
        const f32x2 oth = *(const LAS f32x2*)(HS + (tid ^ 128) * 2);
        const float blast0 = hs0 + oth.x, blast1 = hs1 + oth.y;
        const float eb0 = __expf(blast0), eb1 = __expf(blast1);
        if (th == 0) *(f32x2*)(DEC + (size_t)((dir * 288 + cid) * 4 + h) * 256 + dk0) = (f32x2){eb0, eb1};
        const int fi = dk0 & 63, halfsel = dk0 >> 7; const bool lowpart = (dk0 & 64) == 0;
        const float fr0 = exp2f(-(float)fi * (13.287712379549449f / 64.f)), fr1 = exp2f(-(float)(fi + 1) * (13.287712379549449f / 64.f));
        float cr0 = 1.f, sr0 = 0.f, cr1 = 1.f, sr1 = 0.f;
        if (lat) { const float rp = (float)(cid & 31); sr0 = __sinf(rp * fr0); cr0 = __cosf(rp * fr0); sr1 = __sinf(rp * fr1); cr1 = __cosf(rp * fr1); }
        bf16_t* qo = QIN + ((size_t)dir * MT + row0) * 1024 + ch; bf16_t* ko = KIN + ((size_t)dir * MT + row0) * 1024 + ch;
        float run0 = th ? oth.x : 0.f, run1 = th ? oth.y : 0.f;
        float cc0 = __cosf((float)t0 * fr0), sc0 = __sinf((float)t0 * fr0), cc1 = __cosf((float)t0 * fr1), sc1 = __sinf((float)t0 * fr1);
        const float cd0 = __cosf(fr0), sd0 = __sinf(fr0), cd1 = __cosf(fr1), sd1 = __sinf(fr1);
#pragma unroll 4
        for (int tt = 0; tt < 32; ++tt) { const int t = t0 + tt;
            const float la0 = (float)__builtin_bit_cast(_Float16, (unsigned short)kela[tt]), la1 = (float)__builtin_bit_cast(_Float16, (unsigned short)kelb[tt]);
            const float bc0 = dir ? (blast0 - run0) : (run0 + la0), bc1 = dir ? (blast1 - run1) : (run1 + la1);
            run0 += la0; run1 += la1;
            const unsigned qw = *(const LAS unsigned*)(QL + t * 264 + dk0), kw = *(const LAS unsigned*)(KL + t * 264 + dk0);
            float q0 = lat ? bf_lo(qw) * 0.0625f : 0.f, q1 = lat ? bf_hi(qw) * 0.0625f : 0.f, k0 = bf_lo(kw), k1 = bf_hi(kw);
            if (lat) { const unsigned qpw = *(const LAS unsigned*)(QL + t * 264 + (dk0 ^ 64)), kpw = *(const LAS unsigned*)(KL + t * 264 + (dk0 ^ 64));
                const float q2a = bf_lo(qpw) * 0.0625f, q2b = bf_hi(qpw) * 0.0625f, k2a = bf_lo(kpw), k2b = bf_hi(kpw);
                float c0 = cr0, s0 = sr0, c1 = cr1, s1 = sr1;
                if (halfsel) { s0 = sc0; c0 = cc0; s1 = sc1; c1 = cc1; }
                if (lowpart) { q0 = q0 * c0 - q2a * s0; k0 = k0 * c0 - k2a * s0; q1 = q1 * c1 - q2b * s1; k1 = k1 * c1 - k2b * s1; }
                else { q0 = q0 * c0 + q2a * s0; k0 = k0 * c0 + k2a * s0; q1 = q1 * c1 + q2b * s1; k1 = k1 * c1 + k2b * s1; } }
            const float e0 = __expf(bc0), e1 = __expf(bc1), ie0 = __builtin_amdgcn_rcpf(e0), ie1 = __builtin_amdgcn_rcpf(e1);
            const float ki0 = k0 * ie0, ki1 = k1 * ie1;
            *(unsigned*)(qo + (size_t)t * 1024) = pk_bf16(q0 * e0, q1 * e1);
            *(unsigned*)(ko + (size_t)t * 1024) = pk_bf16(ki0, ki1);
            const unsigned kew = pk_bf16(ki0 * eb0, ki1 * eb1);
            kela[tt] = (bf16_t)(kew & 0xffffu); kelb[tt] = (bf16_t)(kew >> 16);
            { const float nc0 = cc0 * cd0 - sc0 * sd0, ns0 = sc0 * cd0 + cc0 * sd0, nc1 = cc1 * cd1 - sc1 * sd1, ns1 = sc1 * cd1 + cc1 * sd1; cc0 = nc0; sc0 = ns0; cc1 = nc1; sc1 = ns1; }
        }
        __syncthreads();
        {
            const int wv_ = tid >> 6, ln_ = tid & 63;
#pragma unroll
            for (int j = 0; j < 8; ++j) { const int row = wv_ * 64 + j * 8 + (ln_ >> 3), chn = ln_ & 7; const LAS unsigned* kr = (const LAS unsigned*)(KE + row * 66) + chn * 4;
                bf16_t* keo = KENDT + ((size_t)(((row >> 8) * 288 + cid) * 4 + h) * 256 + (row & 255)) * 64 + chn * 8;
                u32x4 o; o.x = kr[0]; o.y = kr[1]; o.z = kr[2]; o.w = kr[3]; *(u32x4*)keo = o; } }
    }
}

__device__ __forceinline__ void phase_glascan(const Params& p, LAS unsigned char* lds, int tid, int bid, int nblk) {
    const bf16_t* QIN = (const bf16_t*)(p.ws + WS_QIN); const bf16_t* KIN = (const bf16_t*)(p.ws + WS_KIN); const bf16_t* KENDT = (const bf16_t*)(p.ws + WS_KENDT);
    const bf16_t* VT1 = (const bf16_t*)(p.ws + WS_VT1); const float* DEC = (const float*)(p.ws + WS_DEC);
    const int wid = tid >> 6, lane = tid & 63, fr = lane & 15, fq = lane >> 4;
    LAS unsigned char* QL = lds;
    LAS unsigned char* KL = lds + 33792;
    LAS unsigned char* EL = lds + 67584;
    LAS unsigned char* AL = lds + 104448;
    LAS float* DL = (LAS float*)(lds + 113664);
    const f32x4 z4 = {0.f, 0.f, 0.f, 0.f};
    for (int item = bid; item < 256; item += nblk) {
        const int seq = item >> 3, dir = (item >> 2) & 1, dvs = item & 3, b = seq >> 2, h = seq & 3;
        const int dv0 = dvs * 128 + wid * 16;
        bf16_t* OFB = (bf16_t*)(p.ws + (dir ? WS_V1 : WS_QK));
        f32x4 S[16];
#pragma unroll
        for (int kt = 0; kt < 16; ++kt) S[kt] = z4;
        auto cid_of = [&](int n_) { const bool lt = n_ >= 4; return dir == 0 ? (lt ? b * 32 + (n_ - 4) : 256 + b * 4 + n_) : (lt ? b * 32 + 31 - (n_ - 4) : 256 + b * 4 + 3 - n_); };
        u32x4 rq[4], rk[4], re[4]; float rd = 0.f; bf16x8 rv[2];
        auto fetch = [&](int n_) { const int cid_ = cid_of(n_); const int row0_ = cid_ * 64; const size_t cb_ = (size_t)((dir * 288 + cid_) * 4 + h);
            if (n_ >= 4) {
#pragma unroll
                for (int i = 0; i < 4; ++i) { const int piece = tid + i * 512, r = piece >> 5, c16 = piece & 31;
                    const size_t go = ((size_t)dir * MT + row0_ + r) * 1024 + h * 256 + c16 * 8;
                    rq[i] = *(const u32x4*)(QIN + go); rk[i] = *(const u32x4*)(KIN + go); } }
#pragma unroll
            for (int i = 0; i < 4; ++i) { const int piece = tid + i * 512, r = piece >> 3, c16 = piece & 7;
                re[i] = *(const u32x4*)(KENDT + (cb_ * 256 + r) * 64 + c16 * 8); }
            if (tid < 256) rd = DEC[cb_ * 256 + tid];
#pragma unroll
            for (int ts = 0; ts < 2; ++ts) rv[ts] = *(const bf16x8*)(VT1 + ((size_t)(cid_ * 4 + h) * 512 + dv0 + fr) * 64 + ts * 32 + fq * 8); };
        fetch(0);
        for (int n = 0; n < 36; ++n) {
            const bool lat = n >= 4;
            const int cid = cid_of(n);
            const int row0 = cid * 64;
            __syncthreads();
            if (lat) {
#pragma unroll
                for (int i = 0; i < 4; ++i) { const int piece = tid + i * 512, r = piece >> 5, c16 = piece & 31;
                    *(LAS u32x4*)(QL + r * 528 + c16 * 16) = rq[i]; *(LAS u32x4*)(KL + r * 528 + c16 * 16) = rk[i]; }
            }
#pragma unroll
            for (int i = 0; i < 4; ++i) { const int piece = tid + i * 512, r = piece >> 3, c16 = piece & 7; *(LAS u32x4*)(EL + r * 144 + c16 * 16) = re[i]; }
            if (tid < 256) DL[tid] = rd;
            bf16x8 vf[2]; vf[0] = rv[0]; vf[1] = rv[1];
            __syncthreads();
            if (n + 1 < 36) fetch(n + 1);
            if (lat) {
                const int tit = wid >> 1;
#pragma unroll
                for (int jj2 = 0; jj2 < 2; ++jj2) { const int jt = 2 * (wid & 1) + jj2;
                    const bool need = dir == 0 ? (jt <= tit) : (jt >= tit);
                    f32x4 a = z4;
                    if (need) {
#pragma unroll
                        for (int kk = 0; kk < 8; ++kk) { const bf16x8 kf = *(const LAS bf16x8*)(KL + (jt * 16 + fr) * 528 + (kk * 32 + fq * 8) * 2), qf = *(const LAS bf16x8*)(QL + (tit * 16 + fr) * 528 + (kk * 32 + fq * 8) * 2);
                            a = MFMA16(kf, qf, a); }
                        const int ti = tit * 16 + fr;
#pragma unroll
                        for (int e = 0; e < 4; ++e) { const int tj = jt * 16 + fq * 4 + e; const bool keep = dir == 0 ? (tj <= ti) : (tj >= ti); a[e] = keep ? a[e] : 0.f; }
                    }
                    u32x2 w; w.x = pk_bf16(a[0], a[1]); w.y = pk_bf16(a[2], a[3]);
                    *(LAS u32x2*)(AL + (tit * 16 + fr) * 144 + (jt * 16 + fq * 4) * 2) = w; }
                f32x4 O[4] = {z4, z4, z4, z4};
#pragma unroll
                for (int kp = 0; kp < 8; ++kp) { u32x4 sw; sw.x = pk_bf16(S[2 * kp][0], S[2 * kp][1]); sw.y = pk_bf16(S[2 * kp][2], S[2 * kp][3]); sw.z = pk_bf16(S[2 * kp + 1][0], S[2 * kp + 1][1]); sw.w = pk_bf16(S[2 * kp + 1][2], S[2 * kp + 1][3]);
                    const bf16x8 sA = __builtin_bit_cast(bf16x8, sw);
#pragma unroll
                    for (int tt = 0; tt < 4; ++tt) { const u32x2 lo = *(const LAS u32x2*)(QL + (tt * 16 + fr) * 528 + (kp * 32 + fq * 4) * 2), hi = *(const LAS u32x2*)(QL + (tt * 16 + fr) * 528 + (kp * 32 + 16 + fq * 4) * 2);
                        u32x4 qw; qw.x = lo.x; qw.y = lo.y; qw.z = hi.x; qw.w = hi.y;
                        O[tt] = MFMA16(sA, __builtin_bit_cast(bf16x8, qw), O[tt]); } }
                __syncthreads();
#pragma unroll
                for (int tt = 0; tt < 4; ++tt) {
#pragma unroll
                    for (int ts = 0; ts < 2; ++ts) { const bf16x8 ab = *(const LAS bf16x8*)(AL + (tt * 16 + fr) * 144 + (ts * 32 + fq * 8) * 2); O[tt] = MFMA16(vf[ts], ab, O[tt]); }
                    u32x2 o; o.x = pk_bf16(O[tt][0], O[tt][1]); o.y = pk_bf16(O[tt][2], O[tt][3]);
                    *(u32x2*)(OFB + (size_t)(row0 + tt * 16 + fr) * 2048 + h * 512 + dv0 + fq * 4) = o; }
            }
#pragma unroll
            for (int kt = 0; kt < 16; ++kt) { const f32x4 d4 = *(const LAS f32x4*)(DL + kt * 16 + fq * 4); S[kt] = S[kt] * d4;
#pragma unroll
                for (int ts = 0; ts < 2; ++ts) { const bf16x8 kf = *(const LAS bf16x8*)(EL + (kt * 16 + fr) * 144 + (ts * 32 + fq * 8) * 2); S[kt] = MFMA16(kf, vf[ts], S[kt]); } }
        }
    }
}

__device__ __forceinline__ void phase_glafin(const Params& p, int gw, int nw, int lane) {
    const bf16_t* OF = (const bf16_t*)(p.ws + WS_QK); const bf16_t* OB = (const bf16_t*)(p.ws + WS_V1); const bf16_t* G1 = (const bf16_t*)(p.ws + WS_G1);
    bf16_t* MIX = (bf16_t*)(p.ws + WS_MIX); const float* NG = p.in[27];
    auto offof = [&](int it_) { return (size_t)(it_ >> 2) * 2048 + (it_ & 3) * 512 + lane * 8; };
    u32x4 a = {0u, 0u, 0u, 0u}, bb = a, g = a; size_t off = 0;
    if (gw < ML * 4) { off = offof(gw); a = *(const u32x4*)(OF + off); bb = *(const u32x4*)(OB + off); g = *(const u32x4*)(G1 + off); }
    for (int it = gw; it < ML * 4; it += nw) {
        u32x4 an = a, bn = bb, gn = g; size_t offn = off;
        if (it + nw < ML * 4) { offn = offof(it + nw); an = *(const u32x4*)(OF + offn); bn = *(const u32x4*)(OB + offn); gn = *(const u32x4*)(G1 + offn); }
        float o[8] = {bf_lo(a.x) + bf_lo(bb.x), bf_hi(a.x) + bf_hi(bb.x), bf_lo(a.y) + bf_lo(bb.y), bf_hi(a.y) + bf_hi(bb.y), bf_lo(a.z) + bf_lo(bb.z), bf_hi(a.z) + bf_hi(bb.z), bf_lo(a.w) + bf_lo(bb.w), bf_hi(a.w) + bf_hi(bb.w)};
        float gg[8] = {bf_lo(g.x), bf_hi(g.x), bf_lo(g.y), bf_hi(g.y), bf_lo(g.z), bf_hi(g.z), bf_lo(g.w), bf_hi(g.w)};
        float ss = 0.f;
#pragma unroll
        for (int e = 0; e < 8; ++e) ss += o[e] * o[e];
        ss = wave_sum(ss);
        const float rstd = rsqrtf(ss * (1.f / 512.f) + 1e-6f);
        const f32x4 n0 = *(const f32x4*)(NG + lane * 8), n1 = *(const f32x4*)(NG + lane * 8 + 4);
        float r[8];
#pragma unroll
        for (int e = 0; e < 8; ++e) { const float ng = e < 4 ? n0[e & 3] : n1[e & 3]; r[e] = o[e] * rstd * ng * (gg[e] / (1.f + __expf(-gg[e]))); }
        u32x4 w; w.x = pk_bf16(r[0], r[1]); w.y = pk_bf16(r[2], r[3]); w.z = pk_bf16(r[4], r[5]); w.w = pk_bf16(r[6], r[7]);
        *(u32x4*)(MIX + off) = w;
        a = an; bb = bn; g = gn; off = offn; }
}


#define XB_TMO      128
#define XB_XCNT(j)  (256  + 64 * (j))
#define XB_XSUB(j)  (1280 + 64 * (j))
#define XB_XGEN(j)  (2304 + 64 * (j))
#define XB_TOP      3328
#define XB_TOPGEN   3392
#define XCD_BAR_WORDS 3456
#define XB_SPIN_CAP (1u << 18)

__device__ __forceinline__ unsigned xb_ld(unsigned* p)              { return __hip_atomic_load(p, __ATOMIC_RELAXED, __HIP_MEMORY_SCOPE_AGENT); }
__device__ __forceinline__ unsigned xb_add(unsigned* p, unsigned v) { return __hip_atomic_fetch_add(p, v, __ATOMIC_RELAXED, __HIP_MEMORY_SCOPE_AGENT); }
__device__ __forceinline__ unsigned xb_xcc_id() { return (unsigned)__builtin_amdgcn_s_getreg((3 << 11) | 20) & 0xFu; }
#define XB_SPIN(cond, bar) do { unsigned _sp = 0; while (cond) { __builtin_amdgcn_s_sleep(1); \
    if ((++_sp & 255u) == 0u) { if (xb_ld(&(bar)[XB_TMO])) break; if (_sp > XB_SPIN_CAP) { atomicAdd(&(bar)[XB_TMO], 1u); break; } } } } while (0)

struct XcdBarrier {
    unsigned* bar; unsigned x;
    volatile LAS unsigned* st;
};

__device__ __forceinline__ XcdBarrier xcd_barrier_post(unsigned* bar, volatile LAS unsigned* st) {
    XcdBarrier b; b.bar = bar; b.x = xb_xcc_id(); b.st = st;
    if (threadIdx.x == 0) (void)xb_add(&bar[XB_XCNT(b.x)], 1u);
    return b;
}
__device__ __forceinline__ void xcd_barrier_complete(unsigned* bar, unsigned x, unsigned& nloc, unsigned& nx) {
    const unsigned G = gridDim.x * gridDim.y * gridDim.z;
    unsigned sum, cnt, mine, sp = 0u;
    for (;;) {
        sum = 0u; cnt = 0u; mine = 0u;
#pragma unroll
        for (unsigned j = 0; j < 16; ++j) { const unsigned c = xb_ld(&bar[XB_XCNT(j)]); sum += c; cnt += (c > 0u) ? 1u : 0u; mine = (j == x) ? c : mine; }
        if (sum == G) break;
        __builtin_amdgcn_s_sleep(1);
        if ((++sp & 255u) == 0u) { if (xb_ld(&bar[XB_TMO])) break; if (sp > XB_SPIN_CAP) { atomicAdd(&bar[XB_TMO], 1u); break; } }
    }
    nloc = mine > 0u ? mine : 1u; nx = cnt > 0u ? cnt : 1u;
}

__device__ __forceinline__ void xcd_barrier(const XcdBarrier& b) {
    asm volatile("s_waitcnt vmcnt(0)" ::: "memory");
    __syncthreads();
    if (threadIdx.x == 0) {
        unsigned* bar = b.bar;
        __builtin_amdgcn_s_waitcnt(0);
        unsigned nloc = b.st[0], nx = b.st[1];
        if (nloc == 0u) { xcd_barrier_complete(bar, b.x, nloc, nx); b.st[0] = nloc; b.st[1] = nx; }
        const unsigned old = xb_add(&bar[XB_XSUB(b.x)], 1u);
        const unsigned gen = old / nloc;
        if (old + 1u == (gen + 1u) * nloc) {
            __builtin_amdgcn_fence(__ATOMIC_RELEASE, "agent");
            asm volatile("s_waitcnt vmcnt(0)" ::: "memory");
            const unsigned og = xb_add(&bar[XB_TOP], 1u);
            const unsigned tg = og / nx;
            if (og + 1u == (tg + 1u) * nx) xb_add(&bar[XB_TOPGEN], 1u);
            else XB_SPIN(xb_ld(&bar[XB_TOPGEN]) == tg, bar);
            __builtin_amdgcn_fence(__ATOMIC_ACQUIRE, "agent");
            xb_add(&bar[XB_XGEN(b.x)], 1u);
            asm volatile("s_waitcnt vmcnt(0)" ::: "memory");
        } else {
            XB_SPIN(xb_ld(&bar[XB_XGEN(b.x)]) == gen, bar);
            __builtin_amdgcn_fence(__ATOMIC_ACQUIRE, "agent");
            asm volatile("s_waitcnt vmcnt(0)" ::: "memory");
        }
    }
    __syncthreads();
}

__global__ void __launch_bounds__(512, 2) fwd_mega(Params p) {
    extern __shared__ __attribute__((aligned(16))) unsigned char smem[];
    LAS unsigned char* lds = (LAS unsigned char*)smem;
    cg::grid_group grid = cg::this_grid();
    const int tid = threadIdx.x, bid = blockIdx.x, nblk = gridDim.x, wid = tid >> 6, lane = tid & 63;
    const int gw = bid * 8 + wid, nw = nblk * 8;
    unsigned char* ws = p.ws;
    float* mod = (float*)(ws + WS_MOD);
    float* XL = p.out; float* XC = (float*)(ws + WS_XC);
    bf16_t* H = (bf16_t*)(ws + WS_H); bf16_t* MIX = (bf16_t*)(ws + WS_MIX);
#define RUN(k) (p.ph_lo <= (k) && (k) < p.ph_hi)
#define SYNC(k) do { if (p.ph_lo <= (k) && (k) + 1 < p.ph_hi) xcd_barrier(xbar); } while (0)
#define GEMM_BF16(k, Aop, Bop, Mv, Nv, Kv, EB) do { if (RUN(k)) { const pg8::Gemm g{(Aop), (Bop), (Mv), (Nv), (Kv), 0}; pg8::StaticOrder S; S.init(g.M, g.N, nblk, bid); __syncthreads(); \
        pg8::gemm_phase<EpiBf16S, pg8::StaticOrder, true, true>(lds, g, S, (EB)); } SYNC(k); } while (0)
#define GEMM_RES(k, Aop, Bop, Mv, Nv, Kv, ER) do { if (RUN(k)) { const pg8::Gemm g{(Aop), (Bop), (Mv), (Nv), (Kv), 0}; pg8::StaticOrder S; S.init(g.M, g.N, nblk, bid); __syncthreads(); \
        pg8::gemm_phase<EpiResid, pg8::StaticOrder, true, true>(lds, g, S, (ER)); } SYNC(k); } while (0)
    volatile LAS unsigned* xst = (volatile LAS unsigned*)(lds + LDS_BYTES - 16);
    if (tid == 0) { xst[0] = 0u; xst[1] = 0u; }
    __syncthreads();
    XcdBarrier xbar = xcd_barrier_post((unsigned*)(ws + 4096), xst);
    if (p.ph_hi - p.ph_lo > 1) grid.sync();
    if (RUN(0)) phase_prep(p, lds, tid, bid, nblk);
    SYNC(0);
    if (RUN(1)) phase_norm(p.in[0], p.in[2], p.in[6], mod, 0, 2048, H, MT, gw, nw, lane);
    SYNC(1);
    GEMM_BF16(2, H, (const bf16_t*)(ws + WS_WABIN), MT, 4096, 2048, (EpiBf16S{(bf16_t*)(ws + WS_PROJ0), nullptr, nullptr, nullptr, P0LD, 0, 1 << 30, 0}));
    if (RUN(3)) phase_vt0(p, tid, bid, nblk);
    SYNC(3);
    if (RUN(4)) phase_mix0(p, lds, tid, bid, nblk);
    SYNC(4);
    if (RUN(5)) phase_s5fin(p, bid * 512 + tid, nblk * 512);
    SYNC(5);
    if (RUN(6)) { const pg8::Gemm g{(const bf16_t*)(ws + WS_GL), (const bf16_t*)(ws + WS_WGLU), MT, 1024, 1024, 0}; pg8::StaticOrder S; S.init(g.M, g.N, nblk, bid); __syncthreads();
        EpiGlu eg{(const bf16_t*)(ws + WS_GL), p.in[23], MIX}; pg8::gemm_phase<EpiGlu, pg8::StaticOrder, true, true>(lds, g, S, eg); }
    SYNC(6);
    GEMM_RES(7, MIX, (const bf16_t*)(ws + WS_WABOUT), MT, 2048, 2048, (EpiResid{p.in[0], p.in[2], XL, XC, mod + 4096}));
    if (RUN(8)) phase_norm(XL, XC, p.in[7], mod, 6144, 8192, H, MT, gw, nw, lane);
    SYNC(8);
    GEMM_BF16(9, H, (const bf16_t*)(ws + WS_W1), MT, 8192, 2048, (EpiBf16S{(bf16_t*)(ws + WS_HID), nullptr, nullptr, nullptr, 8192, 0, 1 << 30, 1}));
    if (RUN(10)) { { const pg8::Gemm g{(const bf16_t*)(ws + WS_HID), (const bf16_t*)(ws + WS_W2), ML, 2048, 8192, 0}; pg8::StaticOrder S; S.init(g.M, g.N, nblk, bid); __syncthreads();
          pg8::gemm_phase<EpiResid, pg8::StaticOrder, true, true>(lds, g, S, (EpiResid{XL, XC, XL, XC, mod + 10240})); }
        { const pg8::Gemm g{(const bf16_t*)(ws + WS_HID), (const bf16_t*)(ws + WS_W2), MT, 2048, 8192, 2048}; SplitOrder S{nblk, bid}; __syncthreads();
          pg8::gemm_phase<EpiPart, SplitOrder, true, true>(lds, g, S, (EpiPart{(float*)(ws + WS_PART)})); } }
    SYNC(10);
    if (RUN(11)) phase_norm(XL, XC, p.in[6] + 2048, mod + 9 * 12288, 0, 2048, H, MT, gw, nw, lane, (const float*)(ws + WS_PART), mod + 8 * 12288 + 10240);
    SYNC(11);
    if (RUN(12)) { const pg8::Gemm g{H, (const bf16_t*)(ws + WS_WGIN), MT, 6400, 2048, 0}; Proj1Order S; S.init(nblk, bid); __syncthreads();
        pg8::gemm_phase<EpiBf16S, Proj1Order, true, true>(lds, g, S, (EpiBf16S{(bf16_t*)(ws + WS_QK), (bf16_t*)(ws + WS_V1), (bf16_t*)(ws + WS_G1), (bf16_t*)(ws + WS_A1), 2048, 256, 2048, 0})); }
    SYNC(12);
    if (RUN(13)) phase_glaprep(p, lds, tid, bid, nblk);
    SYNC(13);
    if (RUN(14)) phase_glascan(p, lds, tid, bid, nblk);
    SYNC(14);
    if (RUN(15)) phase_glafin(p, gw, nw, lane);
    SYNC(15);
    GEMM_RES(16, MIX, (const bf16_t*)(ws + WS_WGOUT), ML, 2048, 2048, (EpiResid{XL, XC, XL, XC, mod + 9 * 12288 + 4096}));
    if (RUN(17)) phase_norm(XL, XC, p.in[7] + 2048, mod + 9 * 12288, 6144, 8192, H, ML, gw, nw, lane);
    SYNC(17);
    GEMM_BF16(18, H, (const bf16_t*)(ws + WS_W1) + (size_t)8192 * 2048, ML, 8192, 2048, (EpiBf16S{(bf16_t*)(ws + WS_HID), nullptr, nullptr, nullptr, 8192, 0, 1 << 30, 1}));
    GEMM_RES(19, (const bf16_t*)(ws + WS_HID), (const bf16_t*)(ws + WS_W2) + (size_t)2048 * 8192, ML, 2048, 8192, (EpiResid{XL, XC, XL, XC, mod + 9 * 12288 + 10240}));
    if (RUN(20)) phase_final_norm(XL, p.in[10], gw, nw, lane);
}

extern "C" void kernel_launch(void* const* d_in, const int* in_sizes, int n_in, void* d_out, int out_size, void* d_ws, size_t ws_size, hipStream_t stream) {
    static int grid = 0;
    if (grid == 0) {
        if (n_in != 29 || ws_size < WS_END) { fprintf(stderr, "kernel_launch: need 29 inputs and %zu bytes of workspace; got %d, %zu\n", (size_t)WS_END, n_in, ws_size); grid = -1; return; }
        int dev = 0, cus = 0, per_cu = 0;
        hipGetDevice(&dev); hipDeviceGetAttribute(&cus, hipDeviceAttributeMultiprocessorCount, dev);
        if (hipFuncSetAttribute((const void*)fwd_mega, hipFuncAttributeMaxDynamicSharedMemorySize, LDS_BYTES) != hipSuccess) { fprintf(stderr, "kernel_launch: hipFuncSetAttribute failed\n"); grid = -1; return; }
        hipOccupancyMaxActiveBlocksPerMultiprocessor(&per_cu, (const void*)fwd_mega, 512, LDS_BYTES);
        if (per_cu < 1) per_cu = 1;
        (void)hipGetLastError();
        grid = cus * per_cu;
        if (grid > 256) grid = 256;
    }
    if (grid < 0) return;
    (void)hipMemsetAsync(d_ws, 0, 32768, stream);
    Params p{};
    for (int i = 0; i < 29; ++i) p.in[i] = (const float*)d_in[i];
    p.out = (float*)d_out; p.ws = (unsigned char*)d_ws;
#ifndef MK_MULTI
    p.ph_lo = 0; p.ph_hi = NPH;
    void* args[] = {&p};
    hipError_t e = hipLaunchCooperativeKernel((const void*)fwd_mega, dim3(grid), dim3(512), args, LDS_BYTES, stream);
    if (e != hipSuccess) fprintf(stderr, "cooperative launch failed: %s (grid %d)\n", hipGetErrorString(e), grid);
#else
    for (int ph = 0; ph < NPH; ++ph) { p.ph_lo = ph; p.ph_hi = ph + 1; hipLaunchKernelGGL(fwd_mega, dim3(grid), dim3(512), LDS_BYTES, stream, p); }
#endif
}
```

```cpp
#include <hip/hip_runtime.h>
#include <hip/hip_cooperative_groups.h>
#include <cstdio>
#include <cstdint>
namespace cg = cooperative_groups;
namespace pg8 {
#define PG8_LAS __attribute__((address_space(3)))
typedef unsigned short bf16_t;
typedef short bf16x8 __attribute__((ext_vector_type(8)));
typedef float f32x4 __attribute__((ext_vector_type(4)));
typedef unsigned u32x4 __attribute__((ext_vector_type(4)));
constexpr int BM = 256, BK = 64, HALF = 128, HTB = HALF * BK * 2  , STAGE_BYTES = 8 * HTB, NXCD = 8, WGM = 8;

__host__ __device__ __forceinline__ int lds_byte(int r, int c) { const int st = (r >> 4) * 2 + (c >> 5), rr = r & 15, cc = c & 31, ob = rr * 64 + cc * 2; return st * 1024 + (ob ^ (((ob >> 9) & 1) << 5)); }
__host__ __device__ __forceinline__ void stage_rc(int b, int& R, int& C) { const int st = b / 1024, sb = b % 1024, swz = sb ^ (((sb >> 9) & 1) << 5); R = (st >> 1) * 16 + swz / 64; C = (st & 1) * 32 + (swz % 64) / 2; }
__host__ __device__ __forceinline__ int perm32(int rho) { const int n = rho >> 4, i = rho & 15; return 8 * (i >> 2) + 4 * n + (i & 3); }

struct Unit { int pm, pn, ks; };
struct Gemm { const bf16_t* A; const bf16_t* Bt; int M, N, K, KL; };

struct StaticOrder {
    int nM, nN, nwg, G, c;
    __host__ __device__ void init(int M, int N, int G_, int c_) { nM = M / BM; nN = N / BM; nwg = nM * nN; G = G_; c = c_; }
    __host__ __device__ bool next(int i, Unit& u) const {
        const long L = (long)i * G + c; if (L >= nwg) return false;
        int wgid = (int)L; { const int q = nwg / NXCD, r = nwg % NXCD, xcd = wgid % NXCD, off = wgid / NXCD; wgid = (xcd < r ? xcd * (q + 1) : r * (q + 1) + (xcd - r) * q) + off; }
        const int nig = WGM * nN, gid = wgid / nig, fm = gid * WGM, gsz = (nM - fm) < WGM ? (nM - fm) : WGM;
        u.pm = fm + ((wgid % nig) % gsz); u.pn = (wgid % nig) / gsz; u.ks = 0; return true;
    }
    __device__ __forceinline__ void a_ready(const Unit&) const {}
    __device__ __forceinline__ void done(const Unit&) const {}
};
typedef __bf16 bf16v2_t0 __attribute__((ext_vector_type(2))); typedef float f32x2_t0 __attribute__((ext_vector_type(2)));
__device__ __forceinline__ unsigned cvt_pk_bf16(float lo, float hi) { const f32x2_t0 f = {lo, hi}; const bf16v2_t0 v = __builtin_convertvector(f, bf16v2_t0); return __builtin_bit_cast(unsigned, v); }
template <class Epi, class Sched, bool ALIGN_EPI = false, bool SP2 = false>
__device__ __forceinline__ void gemm_phase(PG8_LAS unsigned char* lds, const Gemm g, const Sched& S, const Epi& E) {
    const int tid = threadIdx.x, wid = __builtin_amdgcn_readfirstlane(tid >> 6), lane = tid & 63, wr = wid >> 2, wc = wid & 3, fr = lane & 15, fq = lane >> 4;
    const int K = g.K, nt = (g.KL ? g.KL : g.K) / BK; const size_t kspan = (size_t)g.KL * 2;
    unsigned voffA[2], voffB[2];
#pragma unroll
    for (int i = 0; i < 2; ++i) { int R, C; stage_rc(tid * 16 + i * 8192, R, C); const int Rb = Epi::PERM ? ((R & ~31) + perm32(R & 31)) : R;
        voffA[i] = (unsigned)(R * K + C) * 2u; voffB[i] = (unsigned)(Rb * K + C) * 2u; }
    const size_t kstep = (size_t)(BK * 2);
    const size_t hstep = (size_t)HALF * K * 2;
    const size_t tstep = 2 * hstep;
    const unsigned ldsw = (unsigned)wid * 1024u;
    const int aoff = lds_byte(wr * 64 + fr, fq * 8), boff = lds_byte(wc * 32 + fr, fq * 8);
#define PG8_SA(b, h) (((b) * 2 + (h)) * HTB)
#define PG8_SB(b, h) ((4 + (b) * 2 + (h)) * HTB)
#define PG8_STAGE(bufoff, gbase, voff) do { _Pragma("unroll") for (int _i = 0; _i < 2; ++_i) \
        __builtin_amdgcn_global_load_lds((const unsigned*)((const char*)(gbase) + (voff)[_i]), (PG8_LAS unsigned*)(lds + (bufoff) + ldsw + _i * 8192), 16, 0, 0); } while (0)
#define PG8_LDA(dst, b, h) do { _Pragma("unroll") for (int m = 0; m < 4; ++m) _Pragma("unroll") for (int k = 0; k < 2; ++k) dst[m][k] = *(const PG8_LAS bf16x8*)(lds + PG8_SA(b, h) + aoff + m * 2048 + k * 1024); } while (0)
#define PG8_LDB(dst, b, h) do { _Pragma("unroll") for (int n = 0; n < 2; ++n) _Pragma("unroll") for (int k = 0; k < 2; ++k) dst[n][k] = *(const PG8_LAS bf16x8*)(lds + PG8_SB(b, h) + boff + n * 2048 + k * 1024); } while (0)
#define PG8_MMA(ai, bj, At, Bt) do { __builtin_amdgcn_s_setprio(1); _Pragma("unroll") for (int m = 0; m < 4; ++m) _Pragma("unroll") for (int n = 0; n < 2; ++n) _Pragma("unroll") for (int k = 0; k < 2; ++k) \
        acc[ai][bj][m][n] = __builtin_amdgcn_mfma_f32_16x16x32_bf16(Bt[n][k], At[m][k], acc[ai][bj][m][n], 0, 0, 0); __builtin_amdgcn_s_setprio(0); } while (0)
#define PG8_WAIT_V(n) asm volatile("s_waitcnt vmcnt(" #n ")" ::: "memory")
#define PG8_WAIT_L(n) asm volatile("s_waitcnt lgkmcnt(" #n ")" ::: "memory")
#define PG8_BAR __builtin_amdgcn_s_barrier()
#define PG8_SCHED __builtin_amdgcn_sched_barrier(0)
    Unit cur, nxt; int ui = 0;
    if (!S.next(0, cur)) return;
    f32x4 acc[2][2][4][2];
#pragma unroll
    for (int a = 0; a < 2; ++a)
#pragma unroll
        for (int b = 0; b < 2; ++b)
#pragma unroll
            for (int m = 0; m < 4; ++m)
#pragma unroll
                for (int n = 0; n < 2; ++n) acc[a][b][m][n] = (f32x4){0.f, 0.f, 0.f, 0.f};
    bf16x8 At[4][2], B0[2][2], B1[2][2];
    const char* cA = (const char*)g.A + (size_t)cur.pm * tstep + (size_t)cur.ks * kspan; const char* cB = (const char*)g.Bt + (size_t)cur.pn * tstep + (size_t)cur.ks * kspan;
    S.a_ready(cur);
    if constexpr (SP2) {
        PG8_STAGE(PG8_SB(0, 0), cB, voffB); PG8_STAGE(PG8_SB(0, 1), cB + hstep, voffB); PG8_STAGE(PG8_SA(0, 0), cA, voffA); PG8_STAGE(PG8_SA(0, 1), cA + hstep, voffA);
        if (wr == 1) PG8_BAR;
        PG8_WAIT_V(2); PG8_BAR;
        PG8_STAGE(PG8_SB(1, 0), cB + kstep, voffB); PG8_STAGE(PG8_SA(1, 0), cA + kstep, voffA); PG8_STAGE(PG8_SB(1, 1), cB + hstep + kstep, voffB);
        PG8_WAIT_V(6); PG8_BAR;
    } else {
        PG8_STAGE(PG8_SB(0, 0), cB, voffB); PG8_STAGE(PG8_SA(0, 0), cA, voffA); PG8_STAGE(PG8_SB(0, 1), cB + hstep, voffB); PG8_STAGE(PG8_SA(0, 1), cA + hstep, voffA);
        if (wr == 1) PG8_BAR;
        PG8_WAIT_V(4); PG8_BAR;
        PG8_STAGE(PG8_SB(1, 0), cB + kstep, voffB); PG8_STAGE(PG8_SA(1, 0), cA + kstep, voffA); PG8_STAGE(PG8_SB(1, 1), cB + hstep + kstep, voffB);
        PG8_WAIT_V(6); PG8_BAR;
    }
    for (;;) {
        const bool has_next = S.next(ui + 1, nxt);
        const char* nA = has_next ? (const char*)g.A + (size_t)nxt.pm * tstep + (size_t)nxt.ks * kspan : cA; const char* nB = has_next ? (const char*)g.Bt + (size_t)nxt.pn * tstep + (size_t)nxt.ks * kspan : cB;
        for (int t = 0; t < nt; t += 2) {
            const bool last = (t == nt - 2);
            const char* a1 = cA + (size_t)(t + 1) * kstep;
            const char* a2 = last ? nA : cA + (size_t)(t + 2) * kstep; const char* b2 = last ? nB : cB + (size_t)(t + 2) * kstep;
            const char* a3 = a2 + kstep; const char* b3 = b2 + kstep;
            if (last && has_next) S.a_ready(nxt);
            if constexpr (SP2) {
            PG8_LDB(B0, 0, 0); PG8_LDB(B1, 0, 1); PG8_SCHED; PG8_LDA(At, 0, 0); PG8_STAGE(PG8_SA(1, 1), a1 + hstep, voffA);
            PG8_WAIT_V(8); PG8_WAIT_L(0); PG8_BAR; PG8_MMA(0, 0, At, B0); PG8_MMA(0, 1, At, B1); PG8_BAR; PG8_SCHED;
            PG8_LDA(At, 0, 1); PG8_STAGE(PG8_SB(0, 0), b2, voffB); PG8_STAGE(PG8_SB(0, 1), b2 + hstep, voffB); PG8_STAGE(PG8_SA(0, 0), a2, voffA);
            PG8_WAIT_V(8); PG8_WAIT_L(0); PG8_BAR; PG8_MMA(1, 0, At, B0); PG8_MMA(1, 1, At, B1); PG8_BAR; PG8_SCHED;
            PG8_LDB(B0, 1, 0); PG8_LDB(B1, 1, 1); PG8_SCHED; PG8_LDA(At, 1, 0); PG8_STAGE(PG8_SA(0, 1), a2 + hstep, voffA);
            PG8_WAIT_V(8); PG8_WAIT_L(0); PG8_BAR; PG8_MMA(0, 0, At, B0); PG8_MMA(0, 1, At, B1); PG8_BAR; PG8_SCHED;
            PG8_LDA(At, 1, 1); PG8_STAGE(PG8_SB(1, 0), b3, voffB); PG8_STAGE(PG8_SB(1, 1), b3 + hstep, voffB); PG8_STAGE(PG8_SA(1, 0), a3, voffA);
            PG8_WAIT_V(8); PG8_WAIT_L(0); PG8_BAR; PG8_MMA(1, 0, At, B0); PG8_MMA(1, 1, At, B1); PG8_BAR; PG8_SCHED;
            } else {
            PG8_LDB(B0, 0, 0); PG8_SCHED; PG8_LDA(At, 0, 0); PG8_STAGE(PG8_SA(1, 1), a1 + hstep, voffA);
            PG8_WAIT_L(8); PG8_BAR; PG8_WAIT_L(0); PG8_MMA(0, 0, At, B0); PG8_BAR; PG8_SCHED;
            PG8_LDB(B1, 0, 1); PG8_STAGE(PG8_SB(0, 0), b2, voffB);
            PG8_BAR; PG8_WAIT_L(0); PG8_MMA(0, 1, At, B1); PG8_BAR;
            PG8_LDA(At, 0, 1); PG8_STAGE(PG8_SA(0, 0), a2, voffA);
            PG8_BAR; PG8_WAIT_L(0); PG8_MMA(1, 0, At, B0); PG8_BAR; PG8_SCHED;
            PG8_STAGE(PG8_SB(0, 1), b2 + hstep, voffB);
            PG8_WAIT_V(6); PG8_BAR; PG8_MMA(1, 1, At, B1); PG8_BAR;
            PG8_LDB(B0, 1, 0); PG8_SCHED; PG8_LDA(At, 1, 0); PG8_STAGE(PG8_SA(0, 1), a2 + hstep, voffA);
            PG8_WAIT_L(8); PG8_BAR; PG8_WAIT_L(0); PG8_MMA(0, 0, At, B0); PG8_BAR; PG8_SCHED;
            PG8_LDB(B1, 1, 1); PG8_STAGE(PG8_SB(1, 0), b3, voffB);
            PG8_BAR; PG8_WAIT_L(0); PG8_MMA(0, 1, At, B1); PG8_BAR;
            PG8_LDA(At, 1, 1); PG8_STAGE(PG8_SA(1, 0), a3, voffA);
            PG8_BAR; PG8_WAIT_L(0); PG8_MMA(1, 0, At, B0); PG8_BAR; PG8_SCHED;
            PG8_STAGE(PG8_SB(1, 1), b3 + hstep, voffB);
            PG8_WAIT_V(6); PG8_BAR; PG8_MMA(1, 1, At, B1); PG8_BAR;
            }
        }
        if constexpr (ALIGN_EPI) { if (wr == 0) PG8_BAR; }
        if constexpr (!Epi::AFTER_DRAIN) { E(acc, cur, wr, wc, fr, fq); S.done(cur); }
        if (!has_next) break;
#pragma unroll
        for (int a = 0; a < 2; ++a)
#pragma unroll
            for (int b = 0; b < 2; ++b)
#pragma unroll
                for (int m = 0; m < 4; ++m)
#pragma unroll
                    for (int n = 0; n < 2; ++n) acc[a][b][m][n] = (f32x4){0.f, 0.f, 0.f, 0.f};
        cur = nxt; cA = nA; cB = nB; ++ui;
        if constexpr (ALIGN_EPI) { if (wr == 1) PG8_BAR; }
    }
    PG8_WAIT_V(0);
    if constexpr (!ALIGN_EPI) { if (wr == 0) PG8_BAR; }
    PG8_BAR;
    if constexpr (Epi::AFTER_DRAIN) { E.fused(acc, cur, wr, wc, fr, fq, lds, wid, lane); S.done(cur); }
#undef PG8_SA
#undef PG8_SB
#undef PG8_STAGE
#undef PG8_LDA
#undef PG8_LDB
#undef PG8_MMA
#undef PG8_WAIT_V
#undef PG8_WAIT_L
#undef PG8_BAR
#undef PG8_SCHED
}
}

#define LAS __attribute__((address_space(3)))
using pg8::bf16_t; using pg8::bf16x8; using pg8::f32x4; using pg8::u32x4;
typedef unsigned u32x2 __attribute__((ext_vector_type(2)));
typedef float f32x2 __attribute__((ext_vector_type(2)));
#define MFMA16(a, b, c) __builtin_amdgcn_mfma_f32_16x16x32_bf16((a), (b), (c), 0, 0, 0)

constexpr int ML = 16384, MC = 2048, MT = 18432, DM = 2048;
constexpr int LDS_BYTES = 155648;
constexpr int NPH = 21;
constexpr int P0LD = 4160;

constexpr size_t al256(size_t x) { return (x + 255) & ~(size_t)255; }
constexpr size_t WS_MOD   = 32768;
constexpr size_t WS_WABIN = al256(WS_MOD + (size_t)2 * 9 * 12288 * 4);
constexpr size_t WS_WABOUT = WS_WABIN + (size_t)4096 * 2048 * 2;
constexpr size_t WS_WGLU  = WS_WABOUT + (size_t)2048 * 2048 * 2;
constexpr size_t WS_W1    = WS_WGLU + (size_t)1024 * 1024 * 2;
constexpr size_t WS_W2    = WS_W1 + (size_t)2 * 8192 * 2048 * 2;
constexpr size_t WS_WGIN  = WS_W2 + (size_t)2 * 8192 * 2048 * 2;
constexpr size_t WS_WGOUT = WS_WGIN + (size_t)6400 * 2048 * 2;
constexpr size_t WS_XC    = WS_WGOUT + (size_t)2048 * 2048 * 2;
constexpr size_t WS_H     = WS_XC + (size_t)MC * DM * 4;
constexpr size_t WS_MIX   = WS_H + (size_t)MT * DM * 2;
constexpr size_t WS_BIG   = WS_MIX + (size_t)MT * DM * 2;
constexpr size_t WS_PROJ0 = WS_BIG;
constexpr size_t WS_VT0   = WS_PROJ0 + (size_t)MT * P0LD * 2;
constexpr size_t WS_YS5   = WS_VT0 + (size_t)8192 * 2304 * 2;
constexpr size_t WS_GL    = WS_YS5 + (size_t)2 * MT * 1024 * 2;
constexpr size_t WS_L0END = WS_GL + (size_t)MT * 1024 * 2;
constexpr size_t WS_HID   = WS_BIG;
constexpr size_t WS_HIDEND = WS_HID + (size_t)MT * 8192 * 2;
constexpr size_t WS_PART  = WS_HIDEND;
constexpr size_t WS_PARTEND = WS_PART + (size_t)4 * MC * DM * 4;
constexpr size_t WS_QK    = WS_BIG;
constexpr size_t WS_V1    = WS_QK + (size_t)MT * 2048 * 2;
constexpr size_t WS_G1    = WS_V1 + (size_t)MT * 2048 * 2;
constexpr size_t WS_A1    = WS_G1 + (size_t)MT * 2048 * 2;
constexpr size_t WS_QIN   = WS_A1 + (size_t)MT * 256 * 2;
constexpr size_t WS_KIN   = WS_QIN + (size_t)2 * MT * 1024 * 2;
constexpr size_t WS_DEC   = WS_KIN + (size_t)2 * MT * 1024 * 2;
constexpr size_t WS_L1END = WS_DEC + (size_t)2 * 288 * 4 * 256 * 4;
constexpr size_t WS_KENDT = WS_MIX;
constexpr size_t WS_VT1   = WS_H;
constexpr size_t cmax(size_t a, size_t b) { return a > b ? a : b; }
constexpr size_t WS_END   = cmax(cmax(WS_L0END, WS_PARTEND), WS_L1END);

struct Params { const float* in[29]; float* out; unsigned char* ws; int ph_lo, ph_hi; };

typedef __bf16 bf16v2_t __attribute__((ext_vector_type(2)));
__device__ __forceinline__ unsigned pk_bf16(float lo, float hi) { const f32x2 f = {lo, hi}; const bf16v2_t v = __builtin_convertvector(f, bf16v2_t); return __builtin_bit_cast(unsigned, v); }
__device__ __forceinline__ float bf_lo(unsigned u) { return __uint_as_float(u << 16); }
__device__ __forceinline__ float bf_hi(unsigned u) { return __uint_as_float(u & 0xffff0000u); }
__device__ __forceinline__ float bf1(bf16_t h) { return __uint_as_float((unsigned)h << 16); }
__device__ __forceinline__ float wave_sum(float v) {
#pragma unroll
    for (int o = 1; o < 64; o <<= 1) v += __shfl_xor(v, o);
    return v;
}
#define WAVE_LDS_SYNC() asm volatile("s_waitcnt lgkmcnt(0)" ::: "memory")

struct EpiBf16S {
    static constexpr bool PERM = true, AFTER_DRAIN = false;
    bf16_t *O0, *O1, *O2, *O3; int ld0, ld3; int split_cols; int act;
    __device__ __forceinline__ void operator()(const f32x4 (&acc)[2][2][4][2], const pg8::Unit& u, int wr, int wc, int fr, int fq) const {
        int colt = u.pn * 256; const int t = colt / split_cols; colt -= t * split_cols;
        bf16_t* base = t == 0 ? O0 : (t == 1 ? O1 : (t == 2 ? O2 : O3)); const int ld = t == 3 ? ld3 : ld0;
        const int row0 = u.pm * 256 + wr * 64 + fr, col0 = colt + wc * 32 + 8 * fq;
#pragma unroll
        for (int ai = 0; ai < 2; ++ai)
#pragma unroll
            for (int m = 0; m < 4; ++m) { bf16_t* rowp = base + (size_t)(row0 + ai * 128 + m * 16) * ld + col0;
#pragma unroll
                for (int bj = 0; bj < 2; ++bj) { f32x4 v0 = acc[ai][bj][m][0], v1 = acc[ai][bj][m][1];
                    if (act) {
#pragma unroll
                        for (int e = 0; e < 4; ++e) { float a = fmaxf(v0[e], 0.f), b = fmaxf(v1[e], 0.f); v0[e] = a * a; v1[e] = b * b; } }
                    u32x4 w; w.x = pk_bf16(v0[0], v0[1]); w.y = pk_bf16(v0[2], v0[3]); w.z = pk_bf16(v1[0], v1[1]); w.w = pk_bf16(v1[2], v1[3]);
                    *(u32x4*)(rowp + bj * 128) = w; } }
    }
};
struct EpiGlu {
    static constexpr bool PERM = true, AFTER_DRAIN = false;
    const bf16_t* GL; const float* bias; bf16_t* MIX;
    __device__ __forceinline__ void operator()(const f32x4 (&acc)[2][2][4][2], const pg8::Unit& u, int wr, int wc, int fr, int fq) const {
        const int row0 = u.pm * 256 + wr * 64 + fr, col0 = u.pn * 256 + wc * 32 + 8 * fq;
#pragma unroll
        for (int bj = 0; bj < 2; ++bj) { const int col = col0 + bj * 128;
            const f32x4 b0 = *(const f32x4*)(bias + col), b1 = *(const f32x4*)(bias + col + 4);
#pragma unroll
            for (int ai = 0; ai < 2; ++ai)
#pragma unroll
                for (int m = 0; m < 4; ++m) { const size_t row = (size_t)(row0 + ai * 128 + m * 16);
                    const u32x4 g = *(const u32x4*)(GL + row * 1024 + col);
                    const f32x4 v0 = acc[ai][bj][m][0] + b0, v1 = acc[ai][bj][m][1] + b1;
                    float gl[8] = {bf_lo(g.x), bf_hi(g.x), bf_lo(g.y), bf_hi(g.y), bf_lo(g.z), bf_hi(g.z), bf_lo(g.w), bf_hi(g.w)};
                    float o[8];
#pragma unroll
                    for (int e = 0; e < 4; ++e) { o[e] = gl[e] / (1.f + __expf(-v0[e])); o[4 + e] = gl[4 + e] / (1.f + __expf(-v1[e])); }
                    u32x4 w; w.x = pk_bf16(o[0], o[1]); w.y = pk_bf16(o[2], o[3]); w.z = pk_bf16(o[4], o[5]); w.w = pk_bf16(o[6], o[7]);
                    *(u32x4*)(MIX + row * 2048 + 1024 + col) = w; } }
    }
};
struct EpiResid {
    static constexpr bool PERM = true, AFTER_DRAIN = false;
    const float *inL, *inC; float *outL, *outC; const float* gate;
    __device__ __forceinline__ void operator()(const f32x4 (&acc)[2][2][4][2], const pg8::Unit& u, int wr, int wc, int fr, int fq) const {
        const int r0 = u.pm * 256; const bool lat = r0 < ML;
        const char* in = (const char*)(lat ? inL + (size_t)r0 * DM : inC + (size_t)(r0 - ML) * DM);
        char* out = (char*)(lat ? outL + (size_t)r0 * DM : outC + (size_t)(r0 - ML) * DM);
        const char* gp = (const char*)(gate + (size_t)(lat ? (r0 >> 11) : 8) * 12288);
        const unsigned colb = (unsigned)(u.pn * 256 + wc * 32 + 8 * fq) * 4u;
        const unsigned rowb = (unsigned)(wr * 64 + fr) * (unsigned)(DM * 4) + colb;
#pragma unroll
        for (int bj = 0; bj < 2; ++bj) {
            const f32x4 g0 = *(const f32x4*)(gp + colb + bj * 512), g1 = *(const f32x4*)(gp + colb + bj * 512 + 16);
#pragma unroll
            for (int ai = 0; ai < 2; ++ai)
#pragma unroll
                for (int m = 0; m < 4; ++m) { const unsigned off = rowb + (unsigned)((ai * 128 + m * 16) * DM * 4 + bj * 512);
                    const f32x4 x0 = *(const f32x4*)(in + off), x1 = *(const f32x4*)(in + off + 16);
                    *(f32x4*)(out + off) = x0 + g0 * acc[ai][bj][m][0];
                    *(f32x4*)(out + off + 16) = x1 + g1 * acc[ai][bj][m][1]; } }
    }
};

struct EpiPart {
    static constexpr bool PERM = true, AFTER_DRAIN = false;
    float* P;
    __device__ __forceinline__ void operator()(const f32x4 (&acc)[2][2][4][2], const pg8::Unit& u, int wr, int wc, int fr, int fq) const {
        char* out = (char*)(P + ((size_t)u.ks * MC + (size_t)(u.pm * 256 - ML)) * DM);
        const unsigned colb = (unsigned)(u.pn * 256 + wc * 32 + 8 * fq) * 4u;
        const unsigned rowb = (unsigned)(wr * 64 + fr) * (unsigned)(DM * 4) + colb;
#pragma unroll
        for (int bj = 0; bj < 2; ++bj)
#pragma unroll
            for (int ai = 0; ai < 2; ++ai)
#pragma unroll
                for (int m = 0; m < 4; ++m) { const unsigned off = rowb + (unsigned)((ai * 128 + m * 16) * DM * 4 + bj * 512);
                    *(f32x4*)(out + off) = acc[ai][bj][m][0]; *(f32x4*)(out + off + 16) = acc[ai][bj][m][1]; }
    }
};
struct SplitOrder {
    int G, c;
    __device__ bool next(int i, pg8::Unit& u) const { const long L = (long)i * G + c; if (L >= 256) return false; u.ks = (int)(L & 3); u.pn = (int)((L >> 2) & 7); u.pm = 64 + (int)(L >> 5); return true; }
    __device__ __forceinline__ void a_ready(const pg8::Unit&) const {}
    __device__ __forceinline__ void done(const pg8::Unit&) const {}
};

struct Proj1Order {
    pg8::StaticOrder S0; int G, c;
    __device__ void init(int G_, int c_) { S0.init(ML, 6400, G_, c_); G = G_; c = c_; }
    __device__ bool next(int i, pg8::Unit& u) const {
        const long L = (long)i * G + c;
        if (L < 1600) return S0.next(i, u);
        const int j = (int)(L - 1600); if (j >= 104) return false;
        const int jj = j % 13; u.pm = 64 + j / 13; u.pn = jj < 12 ? 4 + jj : 24; u.ks = 0; return true; }
    __device__ __forceinline__ void a_ready(const pg8::Unit&) const {}
    __device__ __forceinline__ void done(const pg8::Unit&) const {}
};

__device__ __forceinline__ void xpose_mat(const float* __restrict__ src, bf16_t* __restrict__ dst, int K, int N, int Npad, LAS unsigned* l32, int tid, int bid, int nblk) {
    const int nkt = K / 128, nnt = Npad / 64, tiles = nkt * nnt;
    const int n = tid & 63, kp0 = (tid >> 6) * 8;
    float cur[16], nxt[16];
    auto fetch = [&](int T, float (&v)[16]) { const int kt = T % nkt, ntile = T / nkt; const int k0 = kt * 128, n0 = ntile * 64; const bool ok = (n0 + n) < N;
        const float* sp = src + (size_t)(k0 + 2 * kp0) * N + n0 + n;
#pragma unroll
        for (int i = 0; i < 16; ++i) v[i] = ok ? sp[(size_t)i * N] : 0.f; };
    int T = bid;
    if (T < tiles) fetch(T, cur);
    for (; T < tiles; T += nblk) {
        const int kt = T % nkt, ntile = T / nkt; const int k0 = kt * 128, n0 = ntile * 64;
        const bool more = T + nblk < tiles;
        if (more) fetch(T + nblk, nxt);
#pragma unroll
        for (int i = 0; i < 8; ++i) l32[n * 65 + kp0 + i] = pk_bf16(cur[2 * i], cur[2 * i + 1]);
        __syncthreads();
#pragma unroll
        for (int q = 0; q < 2; ++q) {
            const int nn = q * 32 + (tid >> 4), j = tid & 15;
            u32x4 w; w.x = l32[nn * 65 + 4 * j]; w.y = l32[nn * 65 + 4 * j + 1]; w.z = l32[nn * 65 + 4 * j + 2]; w.w = l32[nn * 65 + 4 * j + 3];
            *(u32x4*)(dst + (size_t)(n0 + nn) * K + k0 + 8 * j) = w;
        }
        __syncthreads();
        if (more) {
#pragma unroll
            for (int i = 0; i < 16; ++i) cur[i] = nxt[i]; }
    }
}

__device__ __forceinline__ void phase_prep(const Params& p, LAS unsigned char* lds, int tid, int bid, int nblk) {
    const int wid = tid >> 6, lane = tid & 63;
    LAS float* sl = (LAS float*)lds;
    LAS float* red = sl + 9 * 2048;
    for (int i = tid; i < 9 * 2048; i += 512) { const float v = i < 8 * 2048 ? p.in[1][i] : p.in[3][i - 8 * 2048]; sl[i] = v / (1.f + expf(-v)); }
    __syncthreads();
    float* mod = (float*)(p.ws + WS_MOD);
    const int c4 = (lane & 15) * 4, ksub = lane >> 4;
    for (int item = bid; item < 384; item += nblk) {
        const int l = item / 192, cc = (item % 192) * 64;
        const float* W = p.in[4] + (size_t)l * 2048 * 12288 + cc + c4;
        f32x4 acc[9];
#pragma unroll
        for (int r = 0; r < 9; ++r) acc[r] = (f32x4){0.f, 0.f, 0.f, 0.f};
        const int k0 = wid * 256 + ksub;
        for (int kk = 0; kk < 256; kk += 32) {
            f32x4 w[8];
#pragma unroll
            for (int u = 0; u < 8; ++u) w[u] = *(const f32x4*)(W + (size_t)(k0 + kk + 4 * u) * 12288);
#pragma unroll
            for (int u = 0; u < 8; ++u)
#pragma unroll
                for (int r = 0; r < 9; ++r) acc[r] += w[u] * sl[r * 2048 + k0 + kk + 4 * u];
        }
#pragma unroll
        for (int r = 0; r < 9; ++r) {
#pragma unroll
            for (int e = 0; e < 4; ++e) { float v = acc[r][e]; v += __shfl_xor(v, 16); v += __shfl_xor(v, 32); acc[r][e] = v; }
            if (ksub == 0) *(LAS f32x4*)(red + (wid * 9 + r) * 64 + c4) = acc[r]; }
        __syncthreads();
        for (int o = tid; o < 576; o += 512) { const int r = o >> 6, c = o & 63; float s_ = 0.f;
#pragma unroll
            for (int w = 0; w < 8; ++w) s_ += red[(w * 9 + r) * 64 + c];
            mod[(size_t)(l * 9 + r) * 12288 + cc + c] = s_ + p.in[5][l * 12288 + cc + c]; }
        __syncthreads();
    }
    LAS unsigned* l32 = (LAS unsigned*)lds;
    __syncthreads();
    if ((nblk & 1) == 0 && nblk >= 2) { if (bid >= nblk / 2) xpose_mat(p.in[11], (bf16_t*)(p.ws + WS_WABIN), 2048, 4096, 4096, l32, tid, bid - nblk / 2, nblk / 2); }
    else xpose_mat(p.in[11], (bf16_t*)(p.ws + WS_WABIN), 2048, 4096, 4096, l32, tid, bid, nblk);
}

__device__ __forceinline__ void phase_norm(const float* XL, const float* XC, const float* gvec, const float* modl, int sh_off, int sc_off, bf16_t* H, int nrows, int gw, int nw, int lane, const float* PART = nullptr, const float* pgate = nullptr) {
    auto xrow = [&](int r_) { return r_ < ML ? XL + (size_t)r_ * DM : XC + (size_t)(r_ - ML) * DM; };
    f32x4 v[8], vn[8];
    if (gw < nrows) { const float* x0 = xrow(gw);
#pragma unroll
        for (int i = 0; i < 8; ++i) v[i] = *(const f32x4*)(x0 + i * 256 + lane * 4); }
    for (int row = gw; row < nrows; row += nw) {
        const float* mr = modl + (size_t)(row < ML ? (row >> 11) : 8) * 12288;
        if (row + nw < nrows) { const float* xn = xrow(row + nw);
#pragma unroll
            for (int i = 0; i < 8; ++i) vn[i] = *(const f32x4*)(xn + i * 256 + lane * 4); }
        float ss = 0.f;
#pragma unroll
        for (int i = 0; i < 8; ++i) {
            if (PART && row >= ML) { const float* pp = PART + (size_t)(row - ML) * DM + i * 256 + lane * 4;
                const f32x4 ps = (*(const f32x4*)pp + *(const f32x4*)(pp + (size_t)MC * DM)) + (*(const f32x4*)(pp + (size_t)2 * MC * DM) + *(const f32x4*)(pp + (size_t)3 * MC * DM));
                v[i] = v[i] + *(const f32x4*)(pgate + i * 256 + lane * 4) * ps; }
            ss += v[i][0] * v[i][0] + v[i][1] * v[i][1] + v[i][2] * v[i][2] + v[i][3] * v[i][3]; }
        ss = wave_sum(ss);
        const float rstd = rsqrtf(ss * (1.f / 2048.f) + 1e-6f);
#pragma unroll
        for (int i = 0; i < 8; ++i) { const int col = i * 256 + lane * 4;
            const f32x4 g = *(const f32x4*)(gvec + col), sc = *(const f32x4*)(mr + sc_off + col), sh = *(const f32x4*)(mr + sh_off + col);
            const f32x4 y = v[i] * rstd * g * (sc + 1.f) + sh;
            u32x2 w; w.x = pk_bf16(y[0], y[1]); w.y = pk_bf16(y[2], y[3]);
            *(u32x2*)(H + (size_t)row * DM + col) = w; }
#pragma unroll
        for (int i = 0; i < 8; ++i) v[i] = vn[i];
    }
}
__device__ __forceinline__ void phase_final_norm(float* X, const float* gvec, int gw, int nw, int lane) {
    f32x4 v[8], vn[8];
    if (gw < ML) { const float* x0 = X + (size_t)gw * DM;
#pragma unroll
        for (int i = 0; i < 8; ++i) v[i] = *(const f32x4*)(x0 + i * 256 + lane * 4); }
    for (int row = gw; row < ML; row += nw) {
        float* x = X + (size_t)row * DM;
        if (row + nw < ML) { const float* xn = X + (size_t)(row + nw) * DM;
#pragma unroll
            for (int i = 0; i < 8; ++i) vn[i] = *(const f32x4*)(xn + i * 256 + lane * 4); }
        float ss = 0.f;
#pragma unroll
        for (int i = 0; i < 8; ++i) ss += v[i][0] * v[i][0] + v[i][1] * v[i][1] + v[i][2] * v[i][2] + v[i][3] * v[i][3];
        ss = wave_sum(ss);
        const float rstd = rsqrtf(ss * (1.f / 2048.f) + 1e-6f);
#pragma unroll
        for (int i = 0; i < 8; ++i) { const int col = i * 256 + lane * 4; const f32x4 g = *(const f32x4*)(gvec + col); *(f32x4*)(x + col) = v[i] * rstd * g; }
#pragma unroll
        for (int i = 0; i < 8; ++i) v[i] = vn[i];
    }
}

__device__ __forceinline__ void phase_vt0(const Params& p, int tid, int bid, int nblk) {
    const bf16_t* P0 = (const bf16_t*)(p.ws + WS_PROJ0); bf16_t* VT = (bf16_t*)(p.ws + WS_VT0);
    for (int item = bid; item < 576; item += nblk) {
        const int cid = item >> 1, vc = (item & 1) * 512 + tid;
        int b, pos0;
        if (cid < 256) { b = cid >> 5; pos0 = 256 + (cid & 31) * 64; } else { const int cc = cid - 256; b = cc >> 2; pos0 = (cc & 3) * 64; }
        const bf16_t* src = P0 + (size_t)cid * 64 * P0LD + 2048 + vc;
        bf16_t* dst = VT + (((size_t)(b * 8 + (vc >> 7)) * 288 + (pos0 >> 3)) * 128 + (vc & 127)) * 8;
#pragma unroll
        for (int q = 0; q < 8; ++q) { unsigned w[4];
#pragma unroll
            for (int e = 0; e < 4; ++e) { const unsigned lo = src[(size_t)(q * 8 + 2 * e) * P0LD], hi = src[(size_t)(q * 8 + 2 * e + 1) * P0LD]; w[e] = lo | (hi << 16); }
            u32x4 o; o.x = w[0]; o.y = w[1]; o.z = w[2]; o.w = w[3];
            *(u32x4*)(dst + (size_t)q * 1024) = o; }
    }
}

__device__ __forceinline__ void s5_disc(float lr, float li, float dt, float& ar, float& ai, float& f_r, float& f_i) {
    const float mag = expf(lr * dt); float sn, cs; sincosf(li * dt, &sn, &cs);
    ar = mag * cs; ai = mag * sn; const float den = lr * lr + li * li;
    f_r = ((ar - 1.f) * lr + ai * li) / den; f_i = (ai * lr - (ar - 1.f) * li) / den;
}
__device__ __forceinline__ void s5_wave(const Params& p, int sw, LAS unsigned char* wl, int lane) {
    const int b = sw >> 7, g = (sw >> 1) & 63, dir = sw & 1;
    const int fr = lane & 15, fq = lane >> 4;
    const int pg = dir * 64 + g;
    const float* LR = p.in[14] + pg * 64; const float* LI = p.in[15] + pg * 64;
    const float dt = expf(p.in[16][pg]);
    const float* BR = p.in[17] + (size_t)pg * 1024; const float* BI = p.in[18] + (size_t)pg * 1024;
    const float* CR = p.in[19] + (size_t)pg * 1024; const float* CI = p.in[20] + (size_t)pg * 1024;
    float ar, ai; { float t0, t1; s5_disc(LR[lane], LI[lane], dt, ar, ai, t0, t1); }
    bf16x8 bbA[8];
#pragma unroll
    for (int q = 0; q < 8; ++q) {
        const int sg = q * 16 + fr, pp = sg >> 1, part = sg & 1;
        float a_r, a_i, f_r, f_i; s5_disc(LR[pp], LI[pp], dt, a_r, a_i, f_r, f_i);
        u32x4 w = {0u, 0u, 0u, 0u};
        if (fq < 2) {
            const f32x4 br0 = *(const f32x4*)(BR + pp * 16 + fq * 8), br1 = *(const f32x4*)(BR + pp * 16 + fq * 8 + 4);
            const f32x4 bi0 = *(const f32x4*)(BI + pp * 16 + fq * 8), bi1 = *(const f32x4*)(BI + pp * 16 + fq * 8 + 4);
            f32x4 v0, v1;
            if (part == 0) { v0 = br0 * f_r - bi0 * f_i; v1 = br1 * f_r - bi1 * f_i; } else { v0 = bi0 * f_r + br0 * f_i; v1 = bi1 * f_r + br1 * f_i; }
            w.x = pk_bf16(v0[0], v0[1]); w.y = pk_bf16(v0[2], v0[3]); w.z = pk_bf16(v1[0], v1[1]); w.w = pk_bf16(v1[2], v1[3]);
        }
        bbA[q] = __builtin_bit_cast(bf16x8, w);
    }
    bf16x8 cA[4];
#pragma unroll
    for (int kk = 0; kk < 4; ++kk) { const int p0 = kk * 16 + fq * 4;
        const f32x4 cr = *(const f32x4*)(CR + fr * 64 + p0), ci = *(const f32x4*)(CI + fr * 64 + p0);
        u32x4 w; w.x = pk_bf16(cr[0], -ci[0]); w.y = pk_bf16(cr[1], -ci[1]); w.z = pk_bf16(cr[2], -ci[2]); w.w = pk_bf16(cr[3], -ci[3]);
        cA[kk] = __builtin_bit_cast(bf16x8, w); }
    LAS float* BU = (LAS float*)wl;
    LAS unsigned* HH = (LAS unsigned*)(wl + 16 * 132 * 4);
    const bf16_t* P0 = (const bf16_t*)(p.ws + WS_PROJ0);
    bf16_t* YS = (bf16_t*)(p.ws + WS_YS5) + (size_t)dir * MT * 1024;
    float hr = 0.f, hi = 0.f;
    const f32x4 z4 = {0.f, 0.f, 0.f, 0.f};
    auto rowof = [&](int ti_) { const int s = ti_ * 16 + fr;
        return dir == 0 ? (s < 256 ? ML + b * 256 + s : b * 2048 + (s - 256)) : (s < 256 ? ML + b * 256 + 255 - s : b * 2048 + 2047 - (s - 256)); };
    int row_n = rowof(0);
    u32x4 uw_n = {0u, 0u, 0u, 0u};
    if (fq < 2) uw_n = *(const u32x4*)(P0 + (size_t)row_n * P0LD + 3072 + g * 16 + fq * 8);
    for (int ti = 0; ti < 144; ++ti) {
        const int row = row_n; const bf16x8 ub = __builtin_bit_cast(bf16x8, uw_n);
        if (ti + 1 < 144) { row_n = rowof(ti + 1); if (fq < 2) uw_n = *(const u32x4*)(P0 + (size_t)row_n * P0LD + 3072 + g * 16 + fq * 8); }
#pragma unroll
        for (int q = 0; q < 8; ++q) { const f32x4 d = MFMA16(bbA[q], ub, z4); *(LAS f32x4*)(BU + fr * 132 + q * 16 + fq * 4) = d; }
        WAVE_LDS_SYNC();
        f32x2 bu[16];
#pragma unroll
        for (int t = 0; t < 16; ++t) bu[t] = *(const LAS f32x2*)(BU + t * 132 + 2 * lane);
#pragma unroll
        for (int t = 0; t < 16; ++t) {
            const float nr = ar * hr - ai * hi + bu[t].x, ni = ar * hi + ai * hr + bu[t].y; hr = nr; hi = ni;
            HH[t * 68 + lane] = pk_bf16(hr, hi); }
        WAVE_LDS_SYNC();
        f32x4 y = z4;
#pragma unroll
        for (int kk = 0; kk < 4; ++kk) { const bf16x8 hb = *(const LAS bf16x8*)(HH + fr * 68 + kk * 16 + fq * 4); y = MFMA16(cA[kk], hb, y); }
        u32x2 o; o.x = pk_bf16(y[0], y[1]); o.y = pk_bf16(y[2], y[3]);
        *(u32x2*)(YS + (size_t)row * 1024 + g * 16 + fq * 4) = o;
        WAVE_LDS_SYNC();
    }
}

__device__ __forceinline__ void na_item(const Params& p, int item, int lane, const LAS float* RBL) {
    const bf16_t* P0 = (const bf16_t*)(p.ws + WS_PROJ0); const bf16_t* VT = (const bf16_t*)(p.ws + WS_VT0); bf16_t* MIX = (bf16_t*)(p.ws + WS_MIX);
    const int fr = lane & 15, fq = lane >> 4;
    int b, h, c0 = 0, ks0 = 0, nwin = 0, rsA = 0, rsB = 0, rA = 0, rB = 0, qrowA, qrowB;
    if (item < 4096) { b = item >> 9; const int rem = item & 511; h = rem >> 6; const int pr = rem & 63; rA = (pr >> 2) * 2; rB = rA + 1; c0 = (pr & 3) * 16;
        rsA = min(max(rA - 4, 0), 24); rsB = min(max(rB - 4, 0), 24); nwin = rsB - rsA + 8; ks0 = min(max(c0 - 8, 0), 32);
        qrowA = b * 2048 + rA * 64 + c0 + fr; qrowB = qrowA + 64; }
    else { const int it = item - 4096; b = it >> 6; h = (it >> 3) & 7; qrowA = ML + b * 256 + (it & 7) * 32 + fr; qrowB = qrowA + 16; }
    const int nblkk = 8 + nwin;
    bf16x8 qfA[4], qfB[4];
#pragma unroll
    for (int kk = 0; kk < 4; ++kk) { qfA[kk] = *(const bf16x8*)(P0 + (size_t)qrowA * P0LD + h * 128 + kk * 32 + fq * 8); qfB[kk] = *(const bf16x8*)(P0 + (size_t)qrowB * P0LD + h * 128 + kk * 32 + fq * 8); }
    float mA = -1e30f, lA = 0.f, mB = -1e30f, lB = 0.f;
    f32x4 oA[8], oB[8];
    const f32x4 z4 = {0.f, 0.f, 0.f, 0.f};
#pragma unroll
    for (int dt = 0; dt < 8; ++dt) { oA[dt] = z4; oB[dt] = z4; }
    const int qcol = c0 + fr, wst = min(max(qcol - 8, 0), 48);
    auto krow_of = [&](int blk_) { return blk_ < 8 ? ML + b * 256 + blk_ * 32 : b * 2048 + (rsA + blk_ - 8) * 64 + ks0; };
    const int kperm = (fr >> 2) * 8 + (fr & 3);
    bf16x8 kc0[4], kc1[4];
    { const bf16_t* kp0 = P0 + (size_t)(krow_of(0) + kperm) * P0LD + 1024 + h * 128 + fq * 8;
#pragma unroll
      for (int kk = 0; kk < 4; ++kk) { kc0[kk] = *(const bf16x8*)(kp0 + kk * 32); kc1[kk] = *(const bf16x8*)(kp0 + (size_t)4 * P0LD + kk * 32); } }
    for (int blk = 0; blk < nblkk; ++blk) {
        const int wrow = rsA + blk - 8;
        const int vpos0 = blk < 8 ? blk * 32 : 256 + wrow * 64 + ks0;
        const bf16_t* vp = VT + (((size_t)(b * 8 + h) * 288 + (vpos0 >> 3) + fq) * 128 + fr) * 8;
        u32x4 vv[8];
#pragma unroll
        for (int dt = 0; dt < 8; ++dt) vv[dt] = *(const u32x4*)(vp + dt * 128);
        bf16x8 kn0[4], kn1[4];
        { const int nb = blk + 1 < nblkk ? blk + 1 : blk; const bf16_t* kp0 = P0 + (size_t)(krow_of(nb) + kperm) * P0LD + 1024 + h * 128 + fq * 8;
#pragma unroll
          for (int kk = 0; kk < 4; ++kk) { kn0[kk] = *(const bf16x8*)(kp0 + kk * 32); kn1[kk] = *(const bf16x8*)(kp0 + (size_t)4 * P0LD + kk * 32); } }
        f32x4 a0 = z4, a1 = z4, b0 = z4, b1 = z4;
#pragma unroll
        for (int kk = 0; kk < 4; ++kk) { a0 = MFMA16(kc0[kk], qfA[kk], a0); a1 = MFMA16(kc1[kk], qfA[kk], a1); b0 = MFMA16(kc0[kk], qfB[kk], b0); b1 = MFMA16(kc1[kk], qfB[kk], b1); }
        float sA[8], sB[8];
#pragma unroll
        for (int jj = 0; jj < 4; ++jj) { sA[jj] = a0[jj] * 0.08838834764831845f; sA[4 + jj] = a1[jj] * 0.08838834764831845f; sB[jj] = b0[jj] * 0.08838834764831845f; sB[4 + jj] = b1[jj] * 0.08838834764831845f; }
        if (blk >= 8) {
            const bool actA = wrow >= rsA && wrow < rsA + 8, actB = wrow >= rsB && wrow < rsB + 8;
            const int riA = min(max(wrow - rA + 7, 0), 14), riB = min(max(wrow - rB + 7, 0), 14);
            const LAS float* rbA = RBL + (h * 15 + riA) * 31; const LAS float* rbB = RBL + (h * 15 + riB) * 31;
            float bvA[8], bvB[8];
#pragma unroll
            for (int e = 0; e < 8; ++e) { const int ci = min(max(ks0 + fq * 8 + e - qcol + 15, 0), 30); bvA[e] = rbA[ci]; bvB[e] = rbB[ci]; }
#pragma unroll
            for (int e = 0; e < 8; ++e) { const int kcol = ks0 + fq * 8 + e; const bool ok = kcol >= wst && kcol < wst + 16;
                sA[e] = (ok && actA) ? sA[e] + bvA[e] : -1e30f; sB[e] = (ok && actB) ? sB[e] + bvB[e] : -1e30f; } }
        float bmA = sA[0], bmB = sB[0];
#pragma unroll
        for (int e = 1; e < 8; ++e) { bmA = fmaxf(bmA, sA[e]); bmB = fmaxf(bmB, sB[e]); }
        bmA = fmaxf(bmA, __shfl_xor(bmA, 16)); bmA = fmaxf(bmA, __shfl_xor(bmA, 32)); bmB = fmaxf(bmB, __shfl_xor(bmB, 16)); bmB = fmaxf(bmB, __shfl_xor(bmB, 32));
        const float mnA = fmaxf(mA, bmA), alA = __expf(mA - mnA), mnB = fmaxf(mB, bmB), alB = __expf(mB - mnB);
        float psA = 0.f, psB = 0.f;
#pragma unroll
        for (int e = 0; e < 8; ++e) { sA[e] = __expf(sA[e] - mnA); psA += sA[e]; sB[e] = __expf(sB[e] - mnB); psB += sB[e]; }
        psA += __shfl_xor(psA, 16); psA += __shfl_xor(psA, 32); psB += __shfl_xor(psB, 16); psB += __shfl_xor(psB, 32);
        lA = lA * alA + psA; mA = mnA; lB = lB * alB + psB; mB = mnB;
        u32x4 pwA, pwB;
        pwA.x = pk_bf16(sA[0], sA[1]); pwA.y = pk_bf16(sA[2], sA[3]); pwA.z = pk_bf16(sA[4], sA[5]); pwA.w = pk_bf16(sA[6], sA[7]);
        pwB.x = pk_bf16(sB[0], sB[1]); pwB.y = pk_bf16(sB[2], sB[3]); pwB.z = pk_bf16(sB[4], sB[5]); pwB.w = pk_bf16(sB[6], sB[7]);
        const bf16x8 pfA = __builtin_bit_cast(bf16x8, pwA), pfB = __builtin_bit_cast(bf16x8, pwB);
#pragma unroll
        for (int dt = 0; dt < 8; ++dt) { const bf16x8 vf = __builtin_bit_cast(bf16x8, vv[dt]);
            oA[dt] = oA[dt] * alA; oA[dt] = MFMA16(vf, pfA, oA[dt]); oB[dt] = oB[dt] * alB; oB[dt] = MFMA16(vf, pfB, oB[dt]); }
#pragma unroll
        for (int kk = 0; kk < 4; ++kk) { kc0[kk] = kn0[kk]; kc1[kk] = kn1[kk]; }
    }
    const float invA = 1.f / lA, invB = 1.f / lB;
    bf16_t* opA = MIX + (size_t)qrowA * 2048 + h * 128 + fq * 4; bf16_t* opB = MIX + (size_t)qrowB * 2048 + h * 128 + fq * 4;
#pragma unroll
    for (int dt = 0; dt < 8; ++dt) { u32x2 o; o.x = pk_bf16(oA[dt][0] * invA, oA[dt][1] * invA); o.y = pk_bf16(oA[dt][2] * invA, oA[dt][3] * invA); *(u32x2*)(opA + dt * 16) = o;
        u32x2 o2; o2.x = pk_bf16(oB[dt][0] * invB, oB[dt][1] * invB); o2.y = pk_bf16(oB[dt][2] * invB, oB[dt][3] * invB); *(u32x2*)(opB + dt * 16) = o2; }
}

__device__ __forceinline__ void xpose_wave_tile(const float* __restrict__ src, bf16_t* __restrict__ dst, int K, int N, int kt, int ntile, LAS unsigned* l32, int lane) {
    const int k0 = kt * 64, n0 = ntile * 64; const bool ok = (n0 + lane) < N;
    const float* sp = src + (size_t)k0 * N + n0 + lane;
#pragma unroll
    for (int hh = 0; hh < 2; ++hh) { float v[32];
#pragma unroll
        for (int i = 0; i < 32; ++i) v[i] = ok ? sp[(size_t)(hh * 32 + i) * N] : 0.f;
#pragma unroll
        for (int i = 0; i < 16; ++i) l32[lane * 33 + hh * 16 + i] = pk_bf16(v[2 * i], v[2 * i + 1]); }
    WAVE_LDS_SYNC();
#pragma unroll
    for (int j = 0; j < 8; ++j) { const int c = j * 64 + lane, row = c >> 3, chn = c & 7;
        u32x4 w; w.x = l32[row * 33 + chn * 4]; w.y = l32[row * 33 + chn * 4 + 1]; w.z = l32[row * 33 + chn * 4 + 2]; w.w = l32[row * 33 + chn * 4 + 3];
        *(u32x4*)(dst + (size_t)(n0 + row) * K + k0 + chn * 8) = w; }
    WAVE_LDS_SYNC();
}
__device__ __forceinline__ void xpose_item(const Params& p, int tile, LAS unsigned* l32, int lane) {
    const float* src; bf16_t* dst; int K, N, nkt;
    if (tile < 1024) { src = p.in[12]; dst = (bf16_t*)(p.ws + WS_WABOUT); K = 2048; N = 2048; nkt = 32; }
    else if (tile < 1280) { tile -= 1024; src = p.in[22]; dst = (bf16_t*)(p.ws + WS_WGLU); K = 1024; N = 1024; nkt = 16; }
    else if (tile < 5376) { tile -= 1280; src = p.in[8]; dst = (bf16_t*)(p.ws + WS_W1); K = 2048; N = 8192; nkt = 32; }
    else if (tile < 9472) { tile -= 5376; src = p.in[8] + (size_t)2048 * 8192; dst = (bf16_t*)(p.ws + WS_W1) + (size_t)8192 * 2048; K = 2048; N = 8192; nkt = 32; }
    else if (tile < 13568) { tile -= 9472; src = p.in[9]; dst = (bf16_t*)(p.ws + WS_W2); K = 8192; N = 2048; nkt = 128; }
    else if (tile < 17664) { tile -= 13568; src = p.in[9] + (size_t)8192 * 2048; dst = (bf16_t*)(p.ws + WS_W2) + (size_t)2048 * 8192; K = 8192; N = 2048; nkt = 128; }
    else if (tile < 20864) { tile -= 17664; src = p.in[24]; dst = (bf16_t*)(p.ws + WS_WGIN); K = 2048; N = 6176; nkt = 32; }
    else { tile -= 20864; src = p.in[28]; dst = (bf16_t*)(p.ws + WS_WGOUT); K = 2048; N = 2048; nkt = 32; }
    xpose_wave_tile(src, dst, K, N, tile % nkt, tile / nkt, l32, lane);
}

__device__ __forceinline__ void phase_mix0(const Params& p, LAS unsigned char* lds, int tid, int bid, int nblk) {
    const int wid = tid >> 6, lane = tid & 63;
    LAS float* RBL = (LAS float*)(lds + 51200);
    LAS unsigned* XL32 = (LAS unsigned*)(lds + 66560 + wid * 8448);
    for (int i = tid; i < 8 * 15 * 31; i += 512) RBL[i] = p.in[13][i];
    __syncthreads();
    if (wid < 4) { for (int sw = bid * 4 + wid; sw < 1024; sw += nblk * 4) s5_wave(p, sw, lds + wid * 12800, lane); }
    unsigned* ctr = (unsigned*)p.ws + 16;
    for (;;) { unsigned it = 0; if (lane == 0) it = atomicAdd(ctr, 1u); it = __builtin_amdgcn_readfirstlane(it); if (it >= 4608u + 2736u) break;
        if (it < 5472u) { if (it & 1u) { const int t0 = (int)(it >> 1) * 8; for (int j = 0; j < 8; ++j) xpose_item(p, t0 + j, XL32, lane); } else na_item(p, (int)(it >> 1), lane, RBL); }
        else na_item(p, (int)(it - 2736u), lane, RBL); }
}

__device__ __forceinline__ void phase_s5fin(const Params& p, int gt, int nt) {
    const bf16_t* P0 = (const bf16_t*)(p.ws + WS_PROJ0); const bf16_t* YF = (const bf16_t*)(p.ws + WS_YS5); const bf16_t* YB = YF + (size_t)MT * 1024;
    bf16_t* GL = (bf16_t*)(p.ws + WS_GL); const float* Dk = p.in[21];
    for (int i = gt; i < MT * 128; i += nt) { const int row = i >> 7, c8 = (i & 127) * 8;
        const u32x4 u = *(const u32x4*)(P0 + (size_t)row * P0LD + 3072 + c8), yf = *(const u32x4*)(YF + (size_t)row * 1024 + c8), yb = *(const u32x4*)(YB + (size_t)row * 1024 + c8);
        const f32x4 d0 = *(const f32x4*)(Dk + c8), d1 = *(const f32x4*)(Dk + c8 + 4);
        float v[8] = {bf_lo(yf.x) + bf_lo(yb.x) + d0[0] * bf_lo(u.x), bf_hi(yf.x) + bf_hi(yb.x) + d0[1] * bf_hi(u.x), bf_lo(yf.y) + bf_lo(yb.y) + d0[2] * bf_lo(u.y), bf_hi(yf.y) + bf_hi(yb.y) + d0[3] * bf_hi(u.y),
                      bf_lo(yf.z) + bf_lo(yb.z) + d1[0] * bf_lo(u.z), bf_hi(yf.z) + bf_hi(yb.z) + d1[1] * bf_hi(u.z), bf_lo(yf.w) + bf_lo(yb.w) + d1[2] * bf_lo(u.w), bf_hi(yf.w) + bf_hi(yb.w) + d1[3] * bf_hi(u.w)};
#pragma unroll
        for (int e = 0; e < 8; ++e) { const float x = v[e], t = __builtin_amdgcn_rcpf(fabsf(x) * 0.2316418882f + 1.0f);
            float q = t * 0.5307027145f + (-0.7265760135f); q = q * t + 0.7107068705f; q = q * t + (-0.142248368f); q = q * t + 0.127414796f; q = q * t;
            const float m = x * (q * __builtin_amdgcn_exp2f((x * x) * (-0.72134752044f))); v[e] = x < 0.f ? m : x - m; }
        u32x4 w; w.x = pk_bf16(v[0], v[1]); w.y = pk_bf16(v[2], v[3]); w.z = pk_bf16(v[4], v[5]); w.w = pk_bf16(v[6], v[7]);
        *(u32x4*)(GL + (size_t)row * 1024 + c8) = w; }
}

__device__ __forceinline__ void phase_glaprep(const Params& p, LAS unsigned char* lds, int tid, int bid, int nblk) {
    const bf16_t* QK = (const bf16_t*)(p.ws + WS_QK); const bf16_t* V1 = (const bf16_t*)(p.ws + WS_V1); const bf16_t* A1 = (const bf16_t*)(p.ws + WS_A1);
    bf16_t* QIN = (bf16_t*)(p.ws + WS_QIN); bf16_t* KIN = (bf16_t*)(p.ws + WS_KIN); bf16_t* KENDT = (bf16_t*)(p.ws + WS_KENDT); bf16_t* VT1 = (bf16_t*)(p.ws + WS_VT1);
    float* DEC = (float*)(p.ws + WS_DEC);
    LAS float* AC = (LAS float*)lds;
    LAS bf16_t* KE = (LAS bf16_t*)(lds + 8192);
    LAS bf16_t* QL = (LAS bf16_t*)(lds + 8192 + 67584);
    LAS bf16_t* KL = QL + 64 * 264;
    LAS float* HS = (LAS float*)(lds + 143360);
    for (int item = bid; item < 1152; item += nblk) {
        const int cid = item >> 2, h = item & 3; const int row0 = cid * 64; const bool lat = cid < 256;
        __syncthreads();
        { const int t = tid >> 3, c4 = (tid & 7) * 4; const u32x2 a = *(const u32x2*)(A1 + (size_t)(row0 + t) * 256 + c4);
          AC[t * 32 + c4] = bf_lo(a.x); AC[t * 32 + c4 + 1] = bf_hi(a.x); AC[t * 32 + c4 + 2] = bf_lo(a.y); AC[t * 32 + c4 + 3] = bf_hi(a.y); }
#pragma unroll
        for (int i = 0; i < 4; ++i) { const int piece = tid + i * 512, r = piece >> 5, c16 = piece & 31;
            const bf16_t* src = QK + (size_t)(row0 + r) * 2048 + h * 256 + c16 * 8;
            *(LAS u32x4*)(QL + r * 264 + c16 * 8) = *(const u32x4*)src;
            *(LAS u32x4*)(KL + r * 264 + c16 * 8) = *(const u32x4*)(src + 1024); }
        { const bf16_t* src = V1 + (size_t)row0 * 2048 + h * 512 + tid; LAS unsigned* vrow = (LAS unsigned*)(KE + tid * 66);
#pragma unroll
          for (int q = 0; q < 8; ++q) {
#pragma unroll
              for (int e = 0; e < 4; ++e) { const unsigned lo = src[(size_t)(q * 8 + 2 * e) * 2048], hi = src[(size_t)(q * 8 + 2 * e + 1) * 2048]; vrow[q * 4 + e] = lo | (hi << 16); } } }
        __syncthreads();
        { const int wv_ = tid >> 6, ln_ = tid & 63; bf16_t* dstb = VT1 + (size_t)(cid * 4 + h) * 512 * 64;
#pragma unroll
          for (int j = 0; j < 8; ++j) { const int row = wv_ * 64 + j * 8 + (ln_ >> 3), chn = ln_ & 7; const LAS unsigned* kr = (const LAS unsigned*)(KE + row * 66) + chn * 4;
              u32x4 o; o.x = kr[0]; o.y = kr[1]; o.z = kr[2]; o.w = kr[3]; *(u32x4*)(dstb + (size_t)row * 64 + chn * 8) = o; } }
        __syncthreads();
        const int dir = tid >> 8, th = (tid >> 7) & 1, dk0 = (tid & 127) * 2, ch = h * 256 + dk0, t0 = th * 32;
        float wa[16], wb[16];
#pragma unroll
        for (int r = 0; r < 16; ++r) { const f32x2 w2 = *(const f32x2*)(p.in[25] + (size_t)(dir * 16 + r) * 1024 + ch); wa[r] = w2.x; wb[r] = w2.y; }
        const f32x2 ba2 = *(const f32x2*)(p.in[26] + dir * 1024 + ch);
        LAS bf16_t* kela = KE + (dir * 256 + dk0) * 66 + t0;
        LAS bf16_t* kelb = kela + 66;
        float hs0 = 0.f, hs1 = 0.f;
#pragma unroll 4
        for (int tt = 0; tt < 32; ++tt) { const int t = t0 + tt; float z0 = ba2.x, z1 = ba2.y;
#pragma unroll
            for (int r4 = 0; r4 < 4; ++r4) { const f32x4 a = *(const LAS f32x4*)(AC + t * 32 + dir * 16 + r4 * 4);
                z0 += a[0] * wa[r4 * 4] + a[1] * wa[r4 * 4 + 1] + a[2] * wa[r4 * 4 + 2] + a[3] * wa[r4 * 4 + 3];
                z1 += a[0] * wb[r4 * 4] + a[1] * wb[r4 * 4 + 1] + a[2] * wb[r4 * 4 + 2] + a[3] * wb[r4 * 4 + 3]; }
            const _Float16 l0 = (_Float16)((fminf(z0, 0.f) - __logf(1.f + __expf(-fabsf(z0)))) * (1.f / 16.f));
            const _Float16 l1 = (_Float16)((fminf(z1, 0.f) - __logf(1.f + __expf(-fabsf(z1)))) * (1.f / 16.f));
            kela[tt] = __builtin_bit_cast(unsigned short, l0); kelb[tt] = __builtin_bit_cast(unsigned short, l1); hs0 += (float)l0; hs1 += (float)l1; }
        HS[tid * 2] = hs0; HS[tid * 2 + 1] = hs1;
        __syncthreads();
        const f32x2 oth = *(const LAS f32x2*)(HS + (tid ^ 128) * 2);
        const float blast0 = hs0 + oth.x, blast1 = hs1 + oth.y;
        const float eb0 = __expf(blast0), eb1 = __expf(blast1);
        if (th == 0) *(f32x2*)(DEC + (size_t)((dir * 288 + cid) * 4 + h) * 256 + dk0) = (f32x2){eb0, eb1};
        const int fi = dk0 & 63, halfsel = dk0 >> 7; const bool lowpart = (dk0 & 64) == 0;
        const float fr0 = exp2f(-(float)fi * (13.287712379549449f / 64.f)), fr1 = exp2f(-(float)(fi + 1) * (13.287712379549449f / 64.f));
        float cr0 = 1.f, sr0 = 0.f, cr1 = 1.f, sr1 = 0.f;
        if (lat) { const float rp = (float)(cid & 31); sr0 = __sinf(rp * fr0); cr0 = __cosf(rp * fr0); sr1 = __sinf(rp * fr1); cr1 = __cosf(rp * fr1); }
        bf16_t* qo = QIN + ((size_t)dir * MT + row0) * 1024 + ch; bf16_t* ko = KIN + ((size_t)dir * MT + row0) * 1024 + ch;
        float run0 = th ? oth.x : 0.f, run1 = th ? oth.y : 0.f;
        float cc0 = __cosf((float)t0 * fr0), sc0 = __sinf((float)t0 * fr0), cc1 = __cosf((float)t0 * fr1), sc1 = __sinf((float)t0 * fr1);
        const float cd0 = __cosf(fr0), sd0 = __sinf(fr0), cd1 = __cosf(fr1), sd1 = __sinf(fr1);
#pragma unroll 4
        for (int tt = 0; tt < 32; ++tt) { const int t = t0 + tt;
            const float la0 = (float)__builtin_bit_cast(_Float16, (unsigned short)kela[tt]), la1 = (float)__builtin_bit_cast(_Float16, (unsigned short)kelb[tt]);
            const float bc0 = dir ? (blast0 - run0) : (run0 + la0), bc1 = dir ? (blast1 - run1) : (run1 + la1);
            run0 += la0; run1 += la1;
            const unsigned qw = *(const LAS unsigned*)(QL + t * 264 + dk0), kw = *(const LAS unsigned*)(KL + t * 264 + dk0);
            float q0 = lat ? bf_lo(qw) * 0.0625f : 0.f, q1 = lat ? bf_hi(qw) * 0.0625f : 0.f, k0 = bf_lo(kw), k1 = bf_hi(kw);
            if (lat) { const unsigned qpw = *(const LAS unsigned*)(QL + t * 264 + (dk0 ^ 64)), kpw = *(const LAS unsigned*)(KL + t * 264 + (dk0 ^ 64));
                const float q2a = bf_lo(qpw) * 0.0625f, q2b = bf_hi(qpw) * 0.0625f, k2a = bf_lo(kpw), k2b = bf_hi(kpw);
                float c0 = cr0, s0 = sr0, c1 = cr1, s1 = sr1;
                if (halfsel) { s0 = sc0; c0 = cc0; s1 = sc1; c1 = cc1; }
                if (lowpart) { q0 = q0 * c0 - q2a * s0; k0 = k0 * c0 - k2a * s0; q1 = q1 * c1 - q2b * s1; k1 = k1 * c1 - k2b * s1; }
                else { q0 = q0 * c0 + q2a * s0; k0 = k0 * c0 + k2a * s0; q1 = q1 * c1 + q2b * s1; k1 = k1 * c1 + k2b * s1; } }
            const float e0 = __expf(bc0), e1 = __expf(bc1), ie0 = __builtin_amdgcn_rcpf(e0), ie1 = __builtin_amdgcn_rcpf(e1);
            const float ki0 = k0 * ie0, ki1 = k1 * ie1;
            *(unsigned*)(qo + (size_t)t * 1024) = pk_bf16(q0 * e0, q1 * e1);
            *(unsigned*)(ko + (size_t)t * 1024) = pk_bf16(ki0, ki1);
            const unsigned kew = pk_bf16(ki0 * eb0, ki1 * eb1);
            kela[tt] = (bf16_t)(kew & 0xffffu); kelb[tt] = (bf16_t)(kew >> 16);
            { const float nc0 = cc0 * cd0 - sc0 * sd0, ns0 = sc0 * cd0 + cc0 * sd0, nc1 = cc1 * cd1 - sc1 * sd1, ns1 = sc1 * cd1 + cc1 * sd1; cc0 = nc0; sc0 = ns0; cc1 = nc1; sc1 = ns1; }
        }
        __syncthreads();
        {
            const int wv_ = tid >> 6, ln_ = tid & 63;
#pragma unroll
            for (int j = 0; j < 8; ++j) { const int row = wv_ * 64 + j * 8 + (ln_ >> 3), chn = ln_ & 7; const LAS unsigned* kr = (const LAS unsigned*)(KE + row * 66) + chn * 4;
                bf16_t* keo = KENDT + ((size_t)(((row >> 8) * 288 + cid) * 4 + h) * 256 + (row & 255)) * 64 + chn * 8;
                u32x4 o; o.x = kr[0]; o.y = kr[1]; o.z = kr[2]; o.w = kr[3]; *(u32x4*)keo = o; } }
    }
}

__device__ __forceinline__ void phase_glascan(const Params& p, LAS unsigned char* lds, int tid, int bid, int nblk) {
    const bf16_t* QIN = (const bf16_t*)(p.ws + WS_QIN); const bf16_t* KIN = (const bf16_t*)(p.ws + WS_KIN); const bf16_t* KENDT = (const bf16_t*)(p.ws + WS_KENDT);
    const bf16_t* VT1 = (const bf16_t*)(p.ws + WS_VT1); const float* DEC = (const float*)(p.ws + WS_DEC);
    const int wid = tid >> 6, lane = tid & 63, fr = lane & 15, fq = lane >> 4;
    LAS unsigned char* QL = lds;
    LAS unsigned char* KL = lds + 33792;
    LAS unsigned char* EL = lds + 67584;
    LAS unsigned char* AL = lds + 104448;
    LAS float* DL = (LAS float*)(lds + 113664);
    const f32x4 z4 = {0.f, 0.f, 0.f, 0.f};
    for (int item = bid; item < 256; item += nblk) {
        const int seq = item >> 3, dir = (item >> 2) & 1, dvs = item & 3, b = seq >> 2, h = seq & 3;
        const int dv0 = dvs * 128 + wid * 16;
        bf16_t* OFB = (bf16_t*)(p.ws + (dir ? WS_V1 : WS_QK));
        f32x4 S[16];
#pragma unroll
        for (int kt = 0; kt < 16; ++kt) S[kt] = z4;
        auto cid_of = [&](int n_) { const bool lt = n_ >= 4; return dir == 0 ? (lt ? b * 32 + (n_ - 4) : 256 + b * 4 + n_) : (lt ? b * 32 + 31 - (n_ - 4) : 256 + b * 4 + 3 - n_); };
        u32x4 rq[4], rk[4], re[4]; float rd = 0.f; bf16x8 rv[2];
        auto fetch = [&](int n_) { const int cid_ = cid_of(n_); const int row0_ = cid_ * 64; const size_t cb_ = (size_t)((dir * 288 + cid_) * 4 + h);
            if (n_ >= 4) {
#pragma unroll
                for (int i = 0; i < 4; ++i) { const int piece = tid + i * 512, r = piece >> 5, c16 = piece & 31;
                    const size_t go = ((size_t)dir * MT + row0_ + r) * 1024 + h * 256 + c16 * 8;
                    rq[i] = *(const u32x4*)(QIN + go); rk[i] = *(const u32x4*)(KIN + go); } }
#pragma unroll
            for (int i = 0; i < 4; ++i) { const int piece = tid + i * 512, r = piece >> 3, c16 = piece & 7;
                re[i] = *(const u32x4*)(KENDT + (cb_ * 256 + r) * 64 + c16 * 8); }
            if (tid < 256) rd = DEC[cb_ * 256 + tid];
#pragma unroll
            for (int ts = 0; ts < 2; ++ts) rv[ts] = *(const bf16x8*)(VT1 + ((size_t)(cid_ * 4 + h) * 512 + dv0 + fr) * 64 + ts * 32 + fq * 8); };
        fetch(0);
        for (int n = 0; n < 36; ++n) {
            const bool lat = n >= 4;
            const int cid = cid_of(n);
            const int row0 = cid * 64;
            __syncthreads();
            if (lat) {
#pragma unroll
                for (int i = 0; i < 4; ++i) { const int piece = tid + i * 512, r = piece >> 5, c16 = piece & 31;
                    *(LAS u32x4*)(QL + r * 528 + c16 * 16) = rq[i]; *(LAS u32x4*)(KL + r * 528 + c16 * 16) = rk[i]; }
            }
#pragma unroll
            for (int i = 0; i < 4; ++i) { const int piece = tid + i * 512, r = piece >> 3, c16 = piece & 7; *(LAS u32x4*)(EL + r * 144 + c16 * 16) = re[i]; }
            if (tid < 256) DL[tid] = rd;
            bf16x8 vf[2]; vf[0] = rv[0]; vf[1] = rv[1];
            __syncthreads();
            if (n + 1 < 36) fetch(n + 1);
            if (lat) {
                const int tit = wid >> 1;
#pragma unroll
                for (int jj2 = 0; jj2 < 2; ++jj2) { const int jt = 2 * (wid & 1) + jj2;
                    const bool need = dir == 0 ? (jt <= tit) : (jt >= tit);
                    f32x4 a = z4;
                    if (need) {
#pragma unroll
                        for (int kk = 0; kk < 8; ++kk) { const bf16x8 kf = *(const LAS bf16x8*)(KL + (jt * 16 + fr) * 528 + (kk * 32 + fq * 8) * 2), qf = *(const LAS bf16x8*)(QL + (tit * 16 + fr) * 528 + (kk * 32 + fq * 8) * 2);
                            a = MFMA16(kf, qf, a); }
                        const int ti = tit * 16 + fr;
#pragma unroll
                        for (int e = 0; e < 4; ++e) { const int tj = jt * 16 + fq * 4 + e; const bool keep = dir == 0 ? (tj <= ti) : (tj >= ti); a[e] = keep ? a[e] : 0.f; }
                    }
                    u32x2 w; w.x = pk_bf16(a[0], a[1]); w.y = pk_bf16(a[2], a[3]);
                    *(LAS u32x2*)(AL + (tit * 16 + fr) * 144 + (jt * 16 + fq * 4) * 2) = w; }
                f32x4 O[4] = {z4, z4, z4, z4};
#pragma unroll
                for (int kp = 0; kp < 8; ++kp) { u32x4 sw; sw.x = pk_bf16(S[2 * kp][0], S[2 * kp][1]); sw.y = pk_bf16(S[2 * kp][2], S[2 * kp][3]); sw.z = pk_bf16(S[2 * kp + 1][0], S[2 * kp + 1][1]); sw.w = pk_bf16(S[2 * kp + 1][2], S[2 * kp + 1][3]);
                    const bf16x8 sA = __builtin_bit_cast(bf16x8, sw);
#pragma unroll
                    for (int tt = 0; tt < 4; ++tt) { const u32x2 lo = *(const LAS u32x2*)(QL + (tt * 16 + fr) * 528 + (kp * 32 + fq * 4) * 2), hi = *(const LAS u32x2*)(QL + (tt * 16 + fr) * 528 + (kp * 32 + 16 + fq * 4) * 2);
                        u32x4 qw; qw.x = lo.x; qw.y = lo.y; qw.z = hi.x; qw.w = hi.y;
                        O[tt] = MFMA16(sA, __builtin_bit_cast(bf16x8, qw), O[tt]); } }
                __syncthreads();
#pragma unroll
                for (int tt = 0; tt < 4; ++tt) {
#pragma unroll
                    for (int ts = 0; ts < 2; ++ts) { const bf16x8 ab = *(const LAS bf16x8*)(AL + (tt * 16 + fr) * 144 + (ts * 32 + fq * 8) * 2); O[tt] = MFMA16(vf[ts], ab, O[tt]); }
                    u32x2 o; o.x = pk_bf16(O[tt][0], O[tt][1]); o.y = pk_bf16(O[tt][2], O[tt][3]);
                    *(u32x2*)(OFB + (size_t)(row0 + tt * 16 + fr) * 2048 + h * 512 + dv0 + fq * 4) = o; }
            }
#pragma unroll
            for (int kt = 0; kt < 16; ++kt) { const f32x4 d4 = *(const LAS f32x4*)(DL + kt * 16 + fq * 4); S[kt] = S[kt] * d4;
#pragma unroll
                for (int ts = 0; ts < 2; ++ts) { const bf16x8 kf = *(const LAS bf16x8*)(EL + (kt * 16 + fr) * 144 + (ts * 32 + fq * 8) * 2); S[kt] = MFMA16(kf, vf[ts], S[kt]); } }
        }
    }
}

__device__ __forceinline__ void phase_glafin(const Params& p, int gw, int nw, int lane) {
    const bf16_t* OF = (const bf16_t*)(p.ws + WS_QK); const bf16_t* OB = (const bf16_t*)(p.ws + WS_V1); const bf16_t* G1 = (const bf16_t*)(p.ws + WS_G1);
    bf16_t* MIX = (bf16_t*)(p.ws + WS_MIX); const float* NG = p.in[27];
    auto offof = [&](int it_) { return (size_t)(it_ >> 2) * 2048 + (it_ & 3) * 512 + lane * 8; };
    u32x4 a = {0u, 0u, 0u, 0u}, bb = a, g = a; size_t off = 0;
    if (gw < ML * 4) { off = offof(gw); a = *(const u32x4*)(OF + off); bb = *(const u32x4*)(OB + off); g = *(const u32x4*)(G1 + off); }
    for (int it = gw; it < ML * 4; it += nw) {
        u32x4 an = a, bn = bb, gn = g; size_t offn = off;
        if (it + nw < ML * 4) { offn = offof(it + nw); an = *(const u32x4*)(OF + offn); bn = *(const u32x4*)(OB + offn); gn = *(const u32x4*)(G1 + offn); }
        float o[8] = {bf_lo(a.x) + bf_lo(bb.x), bf_hi(a.x) + bf_hi(bb.x), bf_lo(a.y) + bf_lo(bb.y), bf_hi(a.y) + bf_hi(bb.y), bf_lo(a.z) + bf_lo(bb.z), bf_hi(a.z) + bf_hi(bb.z), bf_lo(a.w) + bf_lo(bb.w), bf_hi(a.w) + bf_hi(bb.w)};
        float gg[8] = {bf_lo(g.x), bf_hi(g.x), bf_lo(g.y), bf_hi(g.y), bf_lo(g.z), bf_hi(g.z), bf_lo(g.w), bf_hi(g.w)};
        float ss = 0.f;
#pragma unroll
        for (int e = 0; e < 8; ++e) ss += o[e] * o[e];
        ss = wave_sum(ss);
        const float rstd = rsqrtf(ss * (1.f / 512.f) + 1e-6f);
        const f32x4 n0 = *(const f32x4*)(NG + lane * 8), n1 = *(const f32x4*)(NG + lane * 8 + 4);
        float r[8];
#pragma unroll
        for (int e = 0; e < 8; ++e) { const float ng = e < 4 ? n0[e & 3] : n1[e & 3]; r[e] = o[e] * rstd * ng * (gg[e] / (1.f + __expf(-gg[e]))); }
        u32x4 w; w.x = pk_bf16(r[0], r[1]); w.y = pk_bf16(r[2], r[3]); w.z = pk_bf16(r[4], r[5]); w.w = pk_bf16(r[6], r[7]);
        *(u32x4*)(MIX + off) = w;
        a = an; bb = bn; g = gn; off = offn; }
}


#define XB_TMO      128
#define XB_XCNT(j)  (256  + 64 * (j))
#define XB_XSUB(j)  (1280 + 64 * (j))
#define XB_XGEN(j)  (2304 + 64 * (j))
#define XB_TOP      3328
#define XB_TOPGEN   3392
#define XCD_BAR_WORDS 3456
#define XB_SPIN_CAP (1u << 18)

__device__ __forceinline__ unsigned xb_ld(unsigned* p)              { return __hip_atomic_load(p, __ATOMIC_RELAXED, __HIP_MEMORY_SCOPE_AGENT); }
__device__ __forceinline__ unsigned xb_add(unsigned* p, unsigned v) { return __hip_atomic_fetch_add(p, v, __ATOMIC_RELAXED, __HIP_MEMORY_SCOPE_AGENT); }
__device__ __forceinline__ unsigned xb_xcc_id() { return (unsigned)__builtin_amdgcn_s_getreg((3 << 11) | 20) & 0xFu; }
#define XB_SPIN(cond, bar) do { unsigned _sp = 0; while (cond) { __builtin_amdgcn_s_sleep(1); \
    if ((++_sp & 255u) == 0u) { if (xb_ld(&(bar)[XB_TMO])) break; if (_sp > XB_SPIN_CAP) { atomicAdd(&(bar)[XB_TMO], 1u); break; } } } } while (0)

struct XcdBarrier {
    unsigned* bar; unsigned x;
    volatile LAS unsigned* st;
};

__device__ __forceinline__ XcdBarrier xcd_barrier_post(unsigned* bar, volatile LAS unsigned* st) {
    XcdBarrier b; b.bar = bar; b.x = xb_xcc_id(); b.st = st;
    if (threadIdx.x == 0) (void)xb_add(&bar[XB_XCNT(b.x)], 1u);
    return b;
}
__device__ __forceinline__ void xcd_barrier_complete(unsigned* bar, unsigned x, unsigned& nloc, unsigned& nx) {
    const unsigned G = gridDim.x * gridDim.y * gridDim.z;
    unsigned sum, cnt, mine, sp = 0u;
    for (;;) {
        sum = 0u; cnt = 0u; mine = 0u;
#pragma unroll
        for (unsigned j = 0; j < 16; ++j) { const unsigned c = xb_ld(&bar[XB_XCNT(j)]); sum += c; cnt += (c > 0u) ? 1u : 0u; mine = (j == x) ? c : mine; }
        if (sum == G) break;
        __builtin_amdgcn_s_sleep(1);
        if ((++sp & 255u) == 0u) { if (xb_ld(&bar[XB_TMO])) break; if (sp > XB_SPIN_CAP) { atomicAdd(&bar[XB_TMO], 1u); break; } }
    }
    nloc = mine > 0u ? mine : 1u; nx = cnt > 0u ? cnt : 1u;
}

__device__ __forceinline__ void xcd_barrier(const XcdBarrier& b) {
    asm volatile("s_waitcnt vmcnt(0)" ::: "memory");
    __syncthreads();
    if (threadIdx.x == 0) {
        unsigned* bar = b.bar;
        __builtin_amdgcn_s_waitcnt(0);
        unsigned nloc = b.st[0], nx = b.st[1];
        if (nloc == 0u) { xcd_barrier_complete(bar, b.x, nloc, nx); b.st[0] = nloc; b.st[1] = nx; }
        const unsigned old = xb_add(&bar[XB_XSUB(b.x)], 1u);
        const unsigned gen = old / nloc;
        if (old + 1u == (gen + 1u) * nloc) {
            __builtin_amdgcn_fence(__ATOMIC_RELEASE, "agent");
            asm volatile("s_waitcnt vmcnt(0)" ::: "memory");
            const unsigned og = xb_add(&bar[XB_TOP], 1u);
            const unsigned tg = og / nx;
            if (og + 1u == (tg + 1u) * nx) xb_add(&bar[XB_TOPGEN], 1u);
            else XB_SPIN(xb_ld(&bar[XB_TOPGEN]) == tg, bar);
            __builtin_amdgcn_fence(__ATOMIC_ACQUIRE, "agent");
            xb_add(&bar[XB_XGEN(b.x)], 1u);
            asm volatile("s_waitcnt vmcnt(0)" ::: "memory");
        } else {
            XB_SPIN(xb_ld(&bar[XB_XGEN(b.x)]) == gen, bar);
            __builtin_amdgcn_fence(__ATOMIC_ACQUIRE, "agent");
            asm volatile("s_waitcnt vmcnt(0)" ::: "memory");
        }
    }
    __syncthreads();
}

__global__ void __launch_bounds__(512, 2) fwd_mega(Params p) {
    extern __shared__ __attribute__((aligned(16))) unsigned char smem[];
    LAS unsigned char* lds = (LAS unsigned char*)smem;
    cg::grid_group grid = cg::this_grid();
    const int tid = threadIdx.x, bid = blockIdx.x, nblk = gridDim.x, wid = tid >> 6, lane = tid & 63;
    const int gw = bid * 8 + wid, nw = nblk * 8;
    unsigned char* ws = p.ws;
    float* mod = (float*)(ws + WS_MOD);
    float* XL = p.out; float* XC = (float*)(ws + WS_XC);
    bf16_t* H = (bf16_t*)(ws + WS_H); bf16_t* MIX = (bf16_t*)(ws + WS_MIX);
#define RUN(k) (p.ph_lo <= (k) && (k) < p.ph_hi)
#define SYNC(k) do { if (p.ph_lo <= (k) && (k) + 1 < p.ph_hi) xcd_barrier(xbar); } while (0)
#define GEMM_BF16(k, Aop, Bop, Mv, Nv, Kv, EB) do { if (RUN(k)) { const pg8::Gemm g{(Aop), (Bop), (Mv), (Nv), (Kv), 0}; pg8::StaticOrder S; S.init(g.M, g.N, nblk, bid); __syncthreads(); \
        pg8::gemm_phase<EpiBf16S, pg8::StaticOrder, true, true>(lds, g, S, (EB)); } SYNC(k); } while (0)
#define GEMM_RES(k, Aop, Bop, Mv, Nv, Kv, ER) do { if (RUN(k)) { const pg8::Gemm g{(Aop), (Bop), (Mv), (Nv), (Kv), 0}; pg8::StaticOrder S; S.init(g.M, g.N, nblk, bid); __syncthreads(); \
        pg8::gemm_phase<EpiResid, pg8::StaticOrder, true, true>(lds, g, S, (ER)); } SYNC(k); } while (0)
    volatile LAS unsigned* xst = (volatile LAS unsigned*)(lds + LDS_BYTES - 16);
    if (tid == 0) { xst[0] = 0u; xst[1] = 0u; }
    __syncthreads();
    XcdBarrier xbar = xcd_barrier_post((unsigned*)(ws + 4096), xst);
    if (p.ph_hi - p.ph_lo > 1) grid.sync();
    if (RUN(0)) phase_prep(p, lds, tid, bid, nblk);
    SYNC(0);
    if (RUN(1)) phase_norm(p.in[0], p.in[2], p.in[6], mod, 0, 2048, H, MT, gw, nw, lane);
    SYNC(1);
    GEMM_BF16(2, H, (const bf16_t*)(ws + WS_WABIN), MT, 4096, 2048, (EpiBf16S{(bf16_t*)(ws + WS_PROJ0), nullptr, nullptr, nullptr, P0LD, 0, 1 << 30, 0}));
    if (RUN(3)) phase_vt0(p, tid, bid, nblk);
    SYNC(3);
    if (RUN(4)) phase_mix0(p, lds, tid, bid, nblk);
    SYNC(4);
    if (RUN(5)) phase_s5fin(p, bid * 512 + tid, nblk * 512);
    SYNC(5);
    if (RUN(6)) { const pg8::Gemm g{(const bf16_t*)(ws + WS_GL), (const bf16_t*)(ws + WS_WGLU), MT, 1024, 1024, 0}; pg8::StaticOrder S; S.init(g.M, g.N, nblk, bid); __syncthreads();
        EpiGlu eg{(const bf16_t*)(ws + WS_GL), p.in[23], MIX}; pg8::gemm_phase<EpiGlu, pg8::StaticOrder, true, true>(lds, g, S, eg); }
    SYNC(6);
    GEMM_RES(7, MIX, (const bf16_t*)(ws + WS_WABOUT), MT, 2048, 2048, (EpiResid{p.in[0], p.in[2], XL, XC, mod + 4096}));
    if (RUN(8)) phase_norm(XL, XC, p.in[7], mod, 6144, 8192, H, MT, gw, nw, lane);
    SYNC(8);
    GEMM_BF16(9, H, (const bf16_t*)(ws + WS_W1), MT, 8192, 2048, (EpiBf16S{(bf16_t*)(ws + WS_HID), nullptr, nullptr, nullptr, 8192, 0, 1 << 30, 1}));
    if (RUN(10)) { { const pg8::Gemm g{(const bf16_t*)(ws + WS_HID), (const bf16_t*)(ws + WS_W2), ML, 2048, 8192, 0}; pg8::StaticOrder S; S.init(g.M, g.N, nblk, bid); __syncthreads();
          pg8::gemm_phase<EpiResid, pg8::StaticOrder, true, true>(lds, g, S, (EpiResid{XL, XC, XL, XC, mod + 10240})); }
        { const pg8::Gemm g{(const bf16_t*)(ws + WS_HID), (const bf16_t*)(ws + WS_W2), MT, 2048, 8192, 2048}; SplitOrder S{nblk, bid}; __syncthreads();
          pg8::gemm_phase<EpiPart, SplitOrder, true, true>(lds, g, S, (EpiPart{(float*)(ws + WS_PART)})); } }
    SYNC(10);
    if (RUN(11)) phase_norm(XL, XC, p.in[6] + 2048, mod + 9 * 12288, 0, 2048, H, MT, gw, nw, lane, (const float*)(ws + WS_PART), mod + 8 * 12288 + 10240);
    SYNC(11);
    if (RUN(12)) { const pg8::Gemm g{H, (const bf16_t*)(ws + WS_WGIN), MT, 6400, 2048, 0}; Proj1Order S; S.init(nblk, bid); __syncthreads();
        pg8::gemm_phase<EpiBf16S, Proj1Order, true, true>(lds, g, S, (EpiBf16S{(bf16_t*)(ws + WS_QK), (bf16_t*)(ws + WS_V1), (bf16_t*)(ws + WS_G1), (bf16_t*)(ws + WS_A1), 2048, 256, 2048, 0})); }
    SYNC(12);
    if (RUN(13)) phase_glaprep(p, lds, tid, bid, nblk);
    SYNC(13);
    if (RUN(14)) phase_glascan(p, lds, tid, bid, nblk);
    SYNC(14);
    if (RUN(15)) phase_glafin(p, gw, nw, lane);
    SYNC(15);
    GEMM_RES(16, MIX, (const bf16_t*)(ws + WS_WGOUT), ML, 2048, 2048, (EpiResid{XL, XC, XL, XC, mod + 9 * 12288 + 4096}));
    if (RUN(17)) phase_norm(XL, XC, p.in[7] + 2048, mod + 9 * 12288, 6144, 8192, H, ML, gw, nw, lane);
    SYNC(17);
    GEMM_BF16(18, H, (const bf16_t*)(ws + WS_W1) + (size_t)8192 * 2048, ML, 8192, 2048, (EpiBf16S{(bf16_t*)(ws + WS_HID), nullptr, nullptr, nullptr, 8192, 0, 1 << 30, 1}));
    GEMM_RES(19, (const bf16_t*)(ws + WS_HID), (const bf16_t*)(ws + WS_W2) + (size_t)2048 * 8192, ML, 2048, 8192, (EpiResid{XL, XC, XL, XC, mod + 9 * 12288 + 10240}));
    if (RUN(20)) phase_final_norm(XL, p.in[10], gw, nw, lane);
}

extern "C" void kernel_launch(void* const* d_in, const int* in_sizes, int n_in, void* d_out, int out_size, void* d_ws, size_t ws_size, hipStream_t stream) {
    static int grid = 0;
    if (grid == 0) {
        if (n_in != 29 || ws_size < WS_END) { fprintf(stderr, "kernel_launch: need 29 inputs and %zu bytes of workspace; got %d, %zu\n", (size_t)WS_END, n_in, ws_size); grid = -1; return; }
        int dev = 0, cus = 0, per_cu = 0;
        hipGetDevice(&dev); hipDeviceGetAttribute(&cus, hipDeviceAttributeMultiprocessorCount, dev);
        if (hipFuncSetAttribute((const void*)fwd_mega, hipFuncAttributeMaxDynamicSharedMemorySize, LDS_BYTES) != hipSuccess) { fprintf(stderr, "kernel_launch: hipFuncSetAttribute failed\n"); grid = -1; return; }
        hipOccupancyMaxActiveBlocksPerMultiprocessor(&per_cu, (const void*)fwd_mega, 512, LDS_BYTES);
        if (per_cu < 1) per_cu = 1;
        (void)hipGetLastError();
        grid = cus * per_cu;
        if (grid > 256) grid = 256;
    }
    if (grid < 0) return;
    (void)hipMemsetAsync(d_ws, 0, 32768, stream);
    Params p{};
    for (int i = 0; i < 29; ++i) p.in[i] = (const float*)d_in[i];
    p.out = (float*)d_out; p.ws = (unsigned char*)d_ws;
#ifndef MK_MULTI
    p.ph_lo = 0; p.ph_hi = NPH;
    void* args[] = {&p};
    hipError_t e = hipLaunchCooperativeKernel((const void*)fwd_mega, dim3(grid), dim3(512), args, LDS_BYTES, stream);
    if (e != hipSuccess) fprintf(stderr, "cooperative launch failed: %s (grid %d)\n", hipGetErrorString(e), grid);
#else
    for (int ph = 0; ph < NPH; ++ph) { p.ph_lo = ph; p.ph_hi = ph + 1; hipLaunchKernelGGL(fwd_mega, dim3(grid), dim3(512), LDS_BYTES, stream, p); }
#endif
}
```
